# Optimizing an MI355X kernel written in HIP

```python
import math
import jax, jax.numpy as jnp
from jax import lax
import numpy as np

D_MODEL = 2048
BATCH = 2
SEQ = 16384
DEPTH = 1

D_M = D_MODEL
N_M_HEADS = 8
M_V_DIM = D_M // N_M_HEADS
M_QK_DIM = M_V_DIM // 2
D_QK = N_M_HEADS * M_QK_DIM
D_G = D_MODEL
N_G_HEADS = 8
G_DIM = D_G // N_G_HEADS
D_MIX = D_M + D_G
CHUNK = 128
CONV_W = 4
EPS = 1e-6

COL_SIZES = (D_QK, D_QK, D_M, D_M, D_M, N_M_HEADS, N_M_HEADS, D_G, D_G, D_G)
D_IN = sum(COL_SIZES)

kernel_name = "hymba_mlstm_gmlp_hybrid_layer"


def _rmsnorm(x, w):
    xf = x.astype(jnp.float32)
    r = xf * lax.rsqrt(jnp.mean(xf * xf, axis=-1, keepdims=True) + EPS)
    return (r * w.astype(jnp.float32)).astype(x.dtype)


def _split_cols(h):
    offs = np.cumsum((0,) + COL_SIZES)
    return [h[..., int(offs[i]):int(offs[i + 1])] for i in range(len(COL_SIZES))]


def _causal_depthwise_conv(x, w, b):
    S = x.shape[1]
    xp = jnp.pad(x, ((0, 0), (CONV_W - 1, 0), (0, 0)))
    y = b
    for j in range(CONV_W):
        y = y + w[j] * lax.dynamic_slice_in_dim(xp, j, S, axis=1)
    return y


def _mlstm_chunkwise(q, k, v, log_i, log_f):
    B, S, H, DK = q.shape
    DV = v.shape[-1]
    NC = S // CHUNK

    def to_chunks(a):
        a = a.reshape((B, NC, CHUNK, H) + a.shape[3:])
        perm = (1, 0, 3, 2) + tuple(range(4, a.ndim))
        return a.transpose(perm)

    qc, kc, vc = to_chunks(q), to_chunks(k), to_chunks(v)
    lic, lfc = to_chunks(log_i), to_chunks(log_f)
    causal = jnp.tril(jnp.ones((CHUNK, CHUNK), dtype=bool))

    def step(carry, inp):
        C, n, m = carry
        qb, kb, vb, li, lf = inp
        b = jnp.cumsum(lf, axis=-1)
        D = b[..., :, None] - b[..., None, :] + li[..., None, :]
        D = jnp.where(causal, D, -jnp.inf)
        inter = b + m[..., None]
        m_t = jnp.maximum(inter, jnp.max(D, axis=-1))
        decay = jnp.exp(inter - m_t)
        P = jnp.exp(D - m_t[..., None])
        Sqk = jnp.einsum('bhtd,bhsd->bhts', qb, kb) * P
        num = jnp.einsum('bhts,bhsv->bhtv', Sqk, vb) + decay[..., None] * jnp.einsum('bhtd,bhdv->bhtv', qb, C)
        den = jnp.sum(Sqk, axis=-1) + decay * jnp.einsum('bhtd,bhd->bht', qb, n)
        h = num / jnp.maximum(jnp.abs(den), jnp.exp(-m_t))[..., None]
        bL = b[..., -1]
        wlog = bL[..., None] - b + li
        m_new = jnp.maximum(bL + m, jnp.max(wlog, axis=-1))
        a = jnp.exp(bL + m - m_new)
        ws = jnp.exp(wlog - m_new[..., None])
        C_new = a[..., None, None] * C + jnp.einsum('bhs,bhsd,bhsv->bhdv', ws, kb, vb)
        n_new = a[..., None] * n + jnp.einsum('bhs,bhsd->bhd', ws, kb)
        return (C_new, n_new, m_new), h

    init = (jnp.zeros((B, H, DK, DV), jnp.float32),
            jnp.zeros((B, H, DK), jnp.float32),
            jnp.zeros((B, H), jnp.float32))
    _, hc = lax.scan(step, init, (qc, kc, vc, lic, lfc))
    return hc.transpose(1, 0, 3, 2, 4).reshape(B, S, H, DV)


def _layernorm(x, w, b):
    xf = x.astype(jnp.float32)
    mu = jnp.mean(xf, axis=-1, keepdims=True)
    var = jnp.mean(jnp.square(xf - mu), axis=-1, keepdims=True)
    return (xf - mu) * lax.rsqrt(var + EPS) * w + b


def setup_inputs(seed: int = 0) -> dict:
    key = jax.random.key(seed)
    ks = jax.random.split(key, 14)
    f32 = jnp.float32
    x = jax.random.normal(ks[0], (BATCH, SEQ, D_MODEL), f32)
    norm_w = 1.0 + 0.02 * jax.random.normal(ks[1], (D_MODEL,), f32)
    w_in = jax.random.normal(ks[2], (D_MODEL, D_IN), f32) * D_MODEL ** -0.5
    conv_w = jax.random.normal(ks[3], (CONV_W, 2 * D_QK), f32) * CONV_W ** -0.5
    conv_b = 0.02 * jax.random.normal(ks[4], (2 * D_QK,), f32)
    b_igate = 0.1 * jax.random.normal(ks[5], (N_M_HEADS,), f32)
    b_fgate = 3.0 + 3.0 * jax.random.uniform(ks[6], (N_M_HEADS,), f32)
    mlstm_norm_w = 1.0 + 0.02 * jax.random.normal(ks[7], (D_M,), f32)
    sgu_norm_w = 1.0 + 0.02 * jax.random.normal(ks[8], (D_G,), f32)
    sgu_norm_b = 0.02 * jax.random.normal(ks[9], (D_G,), f32)
    w_spatial = jax.random.normal(ks[10], (N_G_HEADS, CHUNK, CHUNK), f32) * CHUNK ** -0.5
    b_spatial = 1.0 + 0.1 * jax.random.normal(ks[11], (N_G_HEADS, CHUNK), f32)
    w_out = jax.random.normal(ks[12], (D_MIX, D_MODEL), f32) * D_MIX ** -0.5
    final_norm_w = 1.0 + 0.02 * jax.random.normal(ks[13], (D_MODEL,), f32)
    return {"x": x, "norm_w": norm_w, "w_in": w_in, "conv_w": conv_w, "conv_b": conv_b,
            "b_igate": b_igate, "b_fgate": b_fgate, "mlstm_norm_w": mlstm_norm_w,
            "sgu_norm_w": sgu_norm_w, "sgu_norm_b": sgu_norm_b, "w_spatial": w_spatial,
            "b_spatial": b_spatial, "w_out": w_out, "final_norm_w": final_norm_w}


def reference(x, norm_w, w_in, conv_w, conv_b, b_igate, b_fgate, mlstm_norm_w,
              sgu_norm_w, sgu_norm_b, w_spatial, b_spatial, w_out, final_norm_w):
    B, S, _ = x.shape
    NC = S // CHUNK
    f32 = jnp.float32
    h = x
    for _layer in range(DEPTH):
        xn = _rmsnorm(h, norm_w)
        proj = jnp.einsum('bsd,de->bse', xn, w_in).astype(f32)
        q, k, v_m, o_m, z_m, i_pre, f_pre, u_g, v_g, z_g = _split_cols(proj)

        qk = jax.nn.silu(_causal_depthwise_conv(jnp.concatenate([q, k], axis=-1),
                                                 conv_w.astype(f32), conv_b.astype(f32)))
        q = qk[..., :D_QK].reshape(B, S, N_M_HEADS, M_QK_DIM)
        k = qk[..., D_QK:].reshape(B, S, N_M_HEADS, M_QK_DIM) * (M_QK_DIM ** -0.5)
        v = v_m.reshape(B, S, N_M_HEADS, M_V_DIM)
        log_i = i_pre + b_igate.astype(f32)
        log_f = jax.nn.log_sigmoid(f_pre + b_fgate.astype(f32))
        hm = _mlstm_chunkwise(q, k, v, log_i, log_f)
        hm = hm * lax.rsqrt(jnp.mean(hm * hm, axis=-1, keepdims=True) + EPS)
        hm = hm.reshape(B, S, D_M) * mlstm_norm_w.astype(f32)
        y_m = hm * jax.nn.sigmoid(o_m) * jax.nn.silu(z_m)

        u = jax.nn.gelu(u_g)
        vg = jax.nn.gelu(v_g).reshape(B, S, N_G_HEADS, G_DIM)
        vg = _layernorm(vg, sgu_norm_w.reshape(N_G_HEADS, G_DIM).astype(f32),
                        sgu_norm_b.reshape(N_G_HEADS, G_DIM).astype(f32))
        vg = vg.reshape(B, NC, CHUNK, N_G_HEADS, G_DIM)
        w_s = jnp.where(jnp.tril(jnp.ones((CHUNK, CHUNK), dtype=bool)), w_spatial.astype(f32), 0.0)
        sv = jnp.einsum('hts,bnshc->bnthc', w_s, vg) + b_spatial.astype(f32).T[None, None, :, :, None]
        y_g = u * sv.reshape(B, S, D_G) * jax.nn.silu(z_g)

        y = jnp.concatenate([y_m, y_g], axis=-1).astype(x.dtype)
        h = h + jnp.einsum('bse,ed->bsd', y, w_out)
    return _rmsnorm(h, final_norm_w)
```

```cpp
#include <hip/hip_runtime.h>
#include <hip/hip_cooperative_groups.h>
#include <cstdio>
#include <cstdint>
namespace cgx = cooperative_groups;
namespace pg8 {
#define PG8_LAS __attribute__((address_space(3)))
typedef unsigned short bf16_t;
typedef short bf16x8 __attribute__((ext_vector_type(8)));
typedef float f32x4 __attribute__((ext_vector_type(4)));
typedef unsigned u32x4 __attribute__((ext_vector_type(4)));
constexpr int BM = 256, BK = 64, HALF = 128, HTB = HALF * BK * 2  , STAGE_BYTES = 8 * HTB, NXCD = 8, WGM = 4;

__host__ __device__ __forceinline__ int lds_byte(int r, int c) { const int st = (r >> 4) * 2 + (c >> 5), rr = r & 15, cc = c & 31, ob = rr * 64 + cc * 2; return st * 1024 + (ob ^ (((ob >> 9) & 1) << 5)); }
__host__ __device__ __forceinline__ void stage_rc(int b, int& R, int& C) { const int st = b / 1024, sb = b % 1024, swz = sb ^ (((sb >> 9) & 1) << 5); R = (st >> 1) * 16 + swz / 64; C = (st & 1) * 32 + (swz % 64) / 2; }
__host__ __device__ __forceinline__ int perm32(int rho) { const int n = rho >> 4, i = rho & 15; return 8 * (i >> 2) + 4 * n + (i & 3); }

struct Unit { int pm, pn; };
struct Gemm { const bf16_t* A; const bf16_t* Bt; int M, N, K; };

struct StaticOrder {
    int nM, nN, nwg, G, c;
    __host__ __device__ void init(int M, int N, int G_, int c_) { nM = M / BM; nN = N / BM; nwg = nM * nN; G = G_; c = c_; }
    __host__ __device__ bool next(int i, Unit& u) const {
        const long L = (long)i * G + c; if (L >= nwg) return false;
        int wgid = (int)L; { const int q = nwg / NXCD, r = nwg % NXCD, xcd = wgid % NXCD, off = wgid / NXCD; wgid = (xcd < r ? xcd * (q + 1) : r * (q + 1) + (xcd - r) * q) + off; }
        const int nig = WGM * nN, gid = wgid / nig, fm = gid * WGM, gsz = (nM - fm) < WGM ? (nM - fm) : WGM;
        u.pm = fm + ((wgid % nig) % gsz); u.pn = (wgid % nig) / gsz; return true;
    }
    __device__ __forceinline__ void a_ready(const Unit&) const {}
    __device__ __forceinline__ void done(const Unit&) const {}
};

__device__ __forceinline__ unsigned cvt_pk_bf16(float lo, float hi) { unsigned r; asm volatile("v_cvt_pk_bf16_f32 %0, %1, %2" : "=v"(r) : "v"(lo), "v"(hi)); return r; }

template <class Epi, class Sched, bool ALIGN_EPI = false, bool SP2 = false>
__device__ __forceinline__ void gemm_phase(PG8_LAS unsigned char* lds, const Gemm g, const int lda, const Sched& S, const Epi& E) {
    const int tid = threadIdx.x, wid = __builtin_amdgcn_readfirstlane(tid >> 6), lane = tid & 63, wr = wid >> 2, wc = wid & 3, fr = lane & 15, fq = lane >> 4;
    const int K = g.K, nt = K / BK;
    unsigned voffA[2], voffB[2];
#pragma unroll
    for (int i = 0; i < 2; ++i) { int R, C; stage_rc(tid * 16 + i * 8192, R, C); const int Rb = Epi::PERM ? ((R & ~31) + perm32(R & 31)) : R;
        voffA[i] = (unsigned)(R * lda + C) * 2u; voffB[i] = (unsigned)(Rb * K + C) * 2u; }
    const size_t kstep = (size_t)(BK * 2);
    const size_t hstep = (size_t)HALF * K * 2;
    const size_t tstep = 2 * hstep; const size_t hstepA = (size_t)HALF * lda * 2; const size_t tstepA = 2 * hstepA;
    const unsigned ldsw = (unsigned)wid * 1024u;
    const int aoff = lds_byte(wr * 64 + fr, fq * 8), boff = lds_byte(wc * 32 + fr, fq * 8);
#define PG8_SA(b, h) (((b) * 2 + (h)) * HTB)
#define PG8_SB(b, h) ((4 + (b) * 2 + (h)) * HTB)
#define PG8_STAGE(bufoff, gbase, voff) do { _Pragma("unroll") for (int _i = 0; _i < 2; ++_i) \
        __builtin_amdgcn_global_load_lds((const unsigned*)((const char*)(gbase) + (voff)[_i]), (PG8_LAS unsigned*)(lds + (bufoff) + ldsw + _i * 8192), 16, 0, 0); } while (0)
#define PG8_LDA(dst, b, h) do { _Pragma("unroll") for (int m = 0; m < 4; ++m) _Pragma("unroll") for (int k = 0; k < 2; ++k) dst[m][k] = *(const PG8_LAS bf16x8*)(lds + PG8_SA(b, h) + aoff + m * 2048 + k * 1024); } while (0)
#define PG8_LDB(dst, b, h) do { _Pragma("unroll") for (int n = 0; n < 2; ++n) _Pragma("unroll") for (int k = 0; k < 2; ++k) dst[n][k] = *(const PG8_LAS bf16x8*)(lds + PG8_SB(b, h) + boff + n * 2048 + k * 1024); } while (0)
#define PG8_MMA(ai, bj, At, Bt) do { __builtin_amdgcn_s_setprio(1); _Pragma("unroll") for (int m = 0; m < 4; ++m) _Pragma("unroll") for (int n = 0; n < 2; ++n) _Pragma("unroll") for (int k = 0; k < 2; ++k) \
        acc[ai][bj][m][n] = __builtin_amdgcn_mfma_f32_16x16x32_bf16(Bt[n][k], At[m][k], acc[ai][bj][m][n], 0, 0, 0); __builtin_amdgcn_s_setprio(0); } while (0)
#define PG8_WAIT_V(n) asm volatile("s_waitcnt vmcnt(" #n ")" ::: "memory")
#define PG8_WAIT_L(n) asm volatile("s_waitcnt lgkmcnt(" #n ")" ::: "memory")
#define PG8_BAR __builtin_amdgcn_s_barrier()
#define PG8_SCHED __builtin_amdgcn_sched_barrier(0)
    Unit cur, nxt; int ui = 0;
    if (!S.next(0, cur)) return;
    f32x4 acc[2][2][4][2];
#pragma unroll
    for (int a = 0; a < 2; ++a)
#pragma unroll
        for (int b = 0; b < 2; ++b)
#pragma unroll
            for (int m = 0; m < 4; ++m)
#pragma unroll
                for (int n = 0; n < 2; ++n) acc[a][b][m][n] = (f32x4){0.f, 0.f, 0.f, 0.f};
    bf16x8 At[4][2], B0[2][2], B1[2][2];
    const char* cA = (const char*)g.A + (size_t)cur.pm * tstepA; const char* cB = (const char*)g.Bt + (size_t)cur.pn * tstep;
    S.a_ready(cur);
    if constexpr (SP2) {
        PG8_STAGE(PG8_SB(0, 0), cB, voffB); PG8_STAGE(PG8_SB(0, 1), cB + hstep, voffB); PG8_STAGE(PG8_SA(0, 0), cA, voffA); PG8_STAGE(PG8_SA(0, 1), cA + hstepA, voffA);
        if (wr == 1) PG8_BAR;
        PG8_WAIT_V(2); PG8_BAR;
        PG8_STAGE(PG8_SB(1, 0), cB + kstep, voffB); PG8_STAGE(PG8_SA(1, 0), cA + kstep, voffA); PG8_STAGE(PG8_SB(1, 1), cB + hstep + kstep, voffB);
        PG8_WAIT_V(6); PG8_BAR;
    } else {
        PG8_STAGE(PG8_SB(0, 0), cB, voffB); PG8_STAGE(PG8_SA(0, 0), cA, voffA); PG8_STAGE(PG8_SB(0, 1), cB + hstep, voffB); PG8_STAGE(PG8_SA(0, 1), cA + hstepA, voffA);
        if (wr == 1) PG8_BAR;
        PG8_WAIT_V(4); PG8_BAR;
        PG8_STAGE(PG8_SB(1, 0), cB + kstep, voffB); PG8_STAGE(PG8_SA(1, 0), cA + kstep, voffA); PG8_STAGE(PG8_SB(1, 1), cB + hstep + kstep, voffB);
        PG8_WAIT_V(6); PG8_BAR;
    }
    for (;;) {
        const bool has_next = S.next(ui + 1, nxt);
        const char* nA = has_next ? (const char*)g.A + (size_t)nxt.pm * tstepA : cA; const char* nB = has_next ? (const char*)g.Bt + (size_t)nxt.pn * tstep : cB;
        for (int t = 0; t < nt; t += 2) {
            const bool last = (t == nt - 2);
            const char* a1 = cA + (size_t)(t + 1) * kstep;
            const char* a2 = last ? nA : cA + (size_t)(t + 2) * kstep; const char* b2 = last ? nB : cB + (size_t)(t + 2) * kstep;
            const char* a3 = a2 + kstep; const char* b3 = b2 + kstep;
            if (last && has_next) S.a_ready(nxt);
            if constexpr (SP2) {
            PG8_LDB(B0, 0, 0); PG8_LDB(B1, 0, 1); PG8_SCHED; PG8_LDA(At, 0, 0); PG8_STAGE(PG8_SA(1, 1), a1 + hstepA, voffA);
            PG8_WAIT_V(8); PG8_WAIT_L(0); PG8_BAR; PG8_MMA(0, 0, At, B0); PG8_MMA(0, 1, At, B1); PG8_BAR; PG8_SCHED;
            PG8_LDA(At, 0, 1); PG8_STAGE(PG8_SB(0, 0), b2, voffB); PG8_STAGE(PG8_SB(0, 1), b2 + hstep, voffB); PG8_STAGE(PG8_SA(0, 0), a2, voffA);
            PG8_WAIT_V(8); PG8_WAIT_L(0); PG8_BAR; PG8_MMA(1, 0, At, B0); PG8_MMA(1, 1, At, B1); PG8_BAR; PG8_SCHED;
            PG8_LDB(B0, 1, 0); PG8_LDB(B1, 1, 1); PG8_SCHED; PG8_LDA(At, 1, 0); PG8_STAGE(PG8_SA(0, 1), a2 + hstepA, voffA);
            PG8_WAIT_V(8); PG8_WAIT_L(0); PG8_BAR; PG8_MMA(0, 0, At, B0); PG8_MMA(0, 1, At, B1); PG8_BAR; PG8_SCHED;
            PG8_LDA(At, 1, 1); PG8_STAGE(PG8_SB(1, 0), b3, voffB); PG8_STAGE(PG8_SB(1, 1), b3 + hstep, voffB); PG8_STAGE(PG8_SA(1, 0), a3, voffA);
            PG8_WAIT_V(8); PG8_WAIT_L(0); PG8_BAR; PG8_MMA(1, 0, At, B0); PG8_MMA(1, 1, At, B1); PG8_BAR; PG8_SCHED;
            } else {
            PG8_LDB(B0, 0, 0); PG8_SCHED; PG8_LDA(At, 0, 0); PG8_STAGE(PG8_SA(1, 1), a1 + hstepA, voffA);
            PG8_WAIT_L(8); PG8_BAR; PG8_WAIT_L(0); PG8_MMA(0, 0, At, B0); PG8_BAR; PG8_SCHED;
            PG8_LDB(B1, 0, 1); PG8_STAGE(PG8_SB(0, 0), b2, voffB);
            PG8_BAR; PG8_WAIT_L(0); PG8_MMA(0, 1, At, B1); PG8_BAR;
            PG8_LDA(At, 0, 1); PG8_STAGE(PG8_SA(0, 0), a2, voffA);
            PG8_BAR; PG8_WAIT_L(0); PG8_MMA(1, 0, At, B0); PG8_BAR; PG8_SCHED;
            PG8_STAGE(PG8_SB(0, 1), b2 + hstep, voffB);
            PG8_WAIT_V(6); PG8_BAR; PG8_MMA(1, 1, At, B1); PG8_BAR;
            PG8_LDB(B0, 1, 0); PG8_SCHED; PG8_LDA(At, 1, 0); PG8_STAGE(PG8_SA(0, 1), a2 + hstepA, voffA);
            PG8_WAIT_L(8); PG8_BAR; PG8_WAIT_L(0); PG8_MMA(0, 0, At, B0); PG8_BAR; PG8_SCHED;
            PG8_LDB(B1, 1, 1); PG8_STAGE(PG8_SB(1, 0), b3, voffB);
            PG8_BAR; PG8_WAIT_L(0); PG8_MMA(0, 1, At, B1); PG8_BAR;
            PG8_LDA(At, 1, 1); PG8_STAGE(PG8_SA(1, 0), a3, voffA);
            PG8_BAR; PG8_WAIT_L(0); PG8_MMA(1, 0, At, B0); PG8_BAR; PG8_SCHED;
            PG8_STAGE(PG8_SB(1, 1), b3 + hstep, voffB);
            PG8_WAIT_V(6); PG8_BAR; PG8_MMA(1, 1, At, B1); PG8_BAR;
            }
        }
        if constexpr (ALIGN_EPI) { if (wr == 0) PG8_BAR; }
        if constexpr (!Epi::AFTER_DRAIN) { E(acc, cur, wr, wc, fr, fq); S.done(cur); }
        if (!has_next) break;
#pragma unroll
        for (int a = 0; a < 2; ++a)
#pragma unroll
            for (int b = 0; b < 2; ++b)
#pragma unroll
                for (int m = 0; m < 4; ++m)
#pragma unroll
                    for (int n = 0; n < 2; ++n) acc[a][b][m][n] = (f32x4){0.f, 0.f, 0.f, 0.f};
        cur = nxt; cA = nA; cB = nB; ++ui;
        if constexpr (ALIGN_EPI) { if (wr == 1) PG8_BAR; }
    }
    PG8_WAIT_V(0);
    if constexpr (!ALIGN_EPI) { if (wr == 0) PG8_BAR; }
    PG8_BAR;
    if constexpr (Epi::AFTER_DRAIN) { E.fused(acc, cur, wr, wc, fr, fq, lds, wid, lane); S.done(cur); }
#undef PG8_SA
#undef PG8_SB
#undef PG8_STAGE
#undef PG8_LDA
#undef PG8_LDB
#undef PG8_MMA
#undef PG8_WAIT_V
#undef PG8_WAIT_L
#undef PG8_BAR
#undef PG8_SCHED
}
}


namespace hy {
using pg8::bf16_t; using pg8::bf16x8; using pg8::f32x4; using pg8::u32x4; using pg8::cvt_pk_bf16; using pg8::lds_byte;
typedef unsigned u32x2 __attribute__((ext_vector_type(2)));
typedef float f32x2 __attribute__((ext_vector_type(2)));
constexpr int T = 32768, D = 2048, SEQ = 16384, NC = 128, NH = 8, DIN = 14352, N1 = 14336, LDP = 10240, NU = 2048;
constexpr int LDS_BYTES = 147456;
constexpr size_t OFF_P = 0;
constexpr size_t OFF_BT2 = OFF_P + (size_t)T * LDP * 2;
constexpr size_t OFF_CST = OFF_BT2 + (size_t)2048 * 4096 * 2;
constexpr size_t OFF_NSTB = OFF_CST + (size_t)NU * 32768 * 2;
constexpr size_t OFF_DN = OFF_NSTB + (size_t)NU * 128 * 2;
constexpr size_t OFF_GI = OFF_DN + (size_t)NU * 128 * 4;
constexpr size_t OFF_GF = OFF_GI + (size_t)T * 8 * 4;
constexpr size_t OFF_RSTD = OFF_GF + (size_t)T * 8 * 4;
constexpr size_t OFF_ROWSS = OFF_RSTD + (size_t)T * 4;
constexpr size_t OFF_BL = OFF_ROWSS + (size_t)T * 4;
constexpr size_t OFF_MLOC = OFF_BL + (size_t)NU * 4;
constexpr size_t OFF_MST = OFF_MLOC + (size_t)NU * 4;
constexpr size_t OFF_WSV = OFF_MST + (size_t)NU * 4;
constexpr size_t OFF_GS = OFF_WSV + (size_t)T * 8 * 4;
constexpr size_t OFF_BT = OFF_GS + (size_t)T * 8 * 4;
constexpr size_t OFF_CM = OFF_BT + (size_t)T * 8 * 4;
constexpr size_t WS_END = OFF_CM + (size_t)T * 8 * 4;
constexpr size_t OUT_OFF_BT1 = (size_t)T * D * 2;

struct Params {
    const float *x, *norm_w, *w_in, *conv_w, *conv_b, *b_i, *b_f, *mnorm_w, *sgu_w, *sgu_b, *w_sp, *b_sp, *w_out, *fnorm_w;
    float* out; unsigned char* ws;
};

__device__ __forceinline__ float bf_lo(unsigned w) { return __uint_as_float(w << 16); }
__device__ __forceinline__ float bf_hi(unsigned w) { return __uint_as_float(w & 0xffff0000u); }
__device__ __forceinline__ float fexp(float x) { return __builtin_amdgcn_exp2f(x * 1.4426950408889634f); }
__device__ __forceinline__ float frcp(float x) { return __builtin_amdgcn_rcpf(x); }
__device__ __forceinline__ int tile_off(int R, int r, int c) { return (c >> 6) * (R * 128) + lds_byte(r, c & 63); }
__device__ __forceinline__ f32x4 mma(bf16x8 X, bf16x8 Y, f32x4 acc) { return __builtin_amdgcn_mfma_f32_16x16x32_bf16(X, Y, acc, 0, 0, 0); }
__device__ __forceinline__ void lds_wait() { asm volatile("s_waitcnt lgkmcnt(0)" ::: "memory"); }
__device__ __forceinline__ float wave_scan_add(float v, int lane) {
#pragma unroll
    for (int o = 1; o < 64; o <<= 1) { const float t = __shfl_up(v, o); if (lane >= o) v += t; }
    return v;
}
__device__ __forceinline__ float wave_scan_max(float v, int lane) {
#pragma unroll
    for (int o = 1; o < 64; o <<= 1) { const float t = __shfl_up(v, o); if (lane >= o) v = fmaxf(v, t); }
    return v;
}
__device__ __forceinline__ float wave_max(float v) {
#pragma unroll
    for (int o = 1; o < 64; o <<= 1) v = fmaxf(v, __shfl_xor(v, o));
    return v;
}

struct Epi1 {
    static constexpr bool PERM = true, AFTER_DRAIN = false;
    bf16_t* P; bool plain;
    __device__ __forceinline__ void operator()(const f32x4 (&acc)[2][2][4][2], const pg8::Unit& u, int wr, int wc, int fr, int fq) const {
        const int row0 = u.pm * 256 + wr * 64 + fr, cw = wc * 32 + 8 * fq; const int pn = plain ? (u.pn % 16) : u.pn;
        if (pn < 16) {
#pragma unroll
            for (int ai = 0; ai < 2; ++ai)
#pragma unroll
                for (int m = 0; m < 4; ++m) { const int row = row0 + ai * 128 + m * 16; bf16_t* rp = P + (size_t)row * LDP + pn * 256 + cw;
#pragma unroll
                    for (int bj = 0; bj < 2; ++bj) { const f32x4 v0 = acc[ai][bj][m][0], v1 = acc[ai][bj][m][1];
                        u32x4 w; w.x = cvt_pk_bf16(v0[0], v0[1]); w.y = cvt_pk_bf16(v0[2], v0[3]); w.z = cvt_pk_bf16(v1[0], v1[1]); w.w = cvt_pk_bf16(v1[2], v1[3]);
                        *(u32x4*)(rp + bj * 128) = w; } }
        } else if (pn < 48) {
            const bool isg = pn >= 32; const int colb = (isg ? 6144 + (pn - 32) * 128 : 4096 + (pn - 16) * 128) + cw;
#pragma unroll
            for (int ai = 0; ai < 2; ++ai)
#pragma unroll
                for (int m = 0; m < 4; ++m) { const int row = row0 + ai * 128 + m * 16; float r[8];
#pragma unroll
                    for (int n = 0; n < 2; ++n)
#pragma unroll
                        for (int j = 0; j < 4; ++j) { const float a = acc[ai][0][m][n][j], z = acc[ai][1][m][n][j];
                            const float arg = isg ? 1.5957691216f * (a + 0.044715f * a * a * a) : a; const float mult = isg ? a * z : z;
                            r[n * 4 + j] = mult * frcp((1.0f + fexp(-arg)) * (1.0f + fexp(-z))); }
                    u32x4 w; w.x = cvt_pk_bf16(r[0], r[1]); w.y = cvt_pk_bf16(r[2], r[3]); w.z = cvt_pk_bf16(r[4], r[5]); w.w = cvt_pk_bf16(r[6], r[7]);
                    *(u32x4*)(P + (size_t)row * LDP + colb) = w; }
        } else {
            const int colb = 8192 + (pn - 48) * 256 + cw;
#pragma unroll
            for (int ai = 0; ai < 2; ++ai)
#pragma unroll
                for (int m = 0; m < 4; ++m) { const int row = row0 + ai * 128 + m * 16;
#pragma unroll
                    for (int bj = 0; bj < 2; ++bj) { float r[8];
#pragma unroll
                        for (int n = 0; n < 2; ++n)
#pragma unroll
                            for (int j = 0; j < 4; ++j) { const float a = acc[ai][bj][m][n][j]; r[n * 4 + j] = a * frcp(1.0f + fexp(-1.5957691216f * (a + 0.044715f * a * a * a))); }
                        u32x4 w; w.x = cvt_pk_bf16(r[0], r[1]); w.y = cvt_pk_bf16(r[2], r[3]); w.z = cvt_pk_bf16(r[4], r[5]); w.w = cvt_pk_bf16(r[6], r[7]);
                        *(u32x4*)(P + (size_t)row * LDP + colb + bj * 128) = w; } }
        }
    }
};
struct Epi2 {
    static constexpr bool PERM = false, AFTER_DRAIN = false;
    const float* x; float* hout; float* rowss; bool dry;
    __device__ __forceinline__ void operator()(const f32x4 (&acc)[2][2][4][2], const pg8::Unit& u, int wr, int wc, int fr, int fq) const {
        const int row0 = u.pm * 256 + wr * 64 + fr, col0 = u.pn * 256 + wc * 32 + 4 * fq;
#pragma unroll
        for (int ai = 0; ai < 2; ++ai)
#pragma unroll
            for (int m = 0; m < 4; ++m) { const int row = row0 + ai * 128 + m * 16; const size_t off = (size_t)row * D + col0; float ss = 0.f;
#pragma unroll
                for (int bj = 0; bj < 2; ++bj)
#pragma unroll
                    for (int n = 0; n < 2; ++n) { const f32x4 xv = *(const f32x4*)(x + off + bj * 128 + n * 16); const f32x4 hv = xv + acc[ai][bj][m][n];
                        *(f32x4*)(hout + off + bj * 128 + n * 16) = hv; ss += (hv[0] * hv[0] + hv[1] * hv[1]) + (hv[2] * hv[2] + hv[3] * hv[3]); }
                ss += __shfl_xor(ss, 16); ss += __shfl_xor(ss, 32);
                if (fq == 0 && !dry) unsafeAtomicAdd(rowss + row, ss);
                asm volatile("" ::: "memory"); }
    }
};

__device__ __forceinline__ int srcmap(int n) {
    if (n < 4096) return n;
    if (n < 8192) { const int j = (n - 4096) >> 8, r = (n - 4096) & 255; return r < 128 ? 4096 + 128 * j + r : 6144 + 128 * j + (r - 128); }
    if (n < 12288) { const int j = (n - 8192) >> 8, r = (n - 8192) & 255; return r < 128 ? 8208 + 128 * j + r : 12304 + 128 * j + (r - 128); }
    return 10256 + (n - 12288);
}
__device__ __forceinline__ void transpose_item(const float* W, int ldw, int scol, int k0, bf16_t* WT, int K, int n0, float* scr, int lane) {
    const int c4 = lane & 15, rs = lane >> 4;
#pragma unroll 8
    for (int i = 0; i < 16; ++i) { const int kk = 4 * i + rs; const f32x4 v = *(const f32x4*)(W + (size_t)(k0 + kk) * ldw + scol + 4 * c4);
        float* d = scr + kk * 65 + 4 * c4; d[0] = v[0]; d[1] = v[1]; d[2] = v[2]; d[3] = v[3]; }
    lds_wait();
    const int c = lane & 7;
#pragma unroll
    for (int j = 0; j < 8; ++j) { const int n = (lane >> 3) + 8 * j; const float* s = scr + (8 * c) * 65 + n;
        u32x4 o; o.x = cvt_pk_bf16(s[0 * 65], s[1 * 65]); o.y = cvt_pk_bf16(s[2 * 65], s[3 * 65]); o.z = cvt_pk_bf16(s[4 * 65], s[5 * 65]); o.w = cvt_pk_bf16(s[6 * 65], s[7 * 65]);
        *(u32x4*)(WT + (size_t)(n0 + n) * K + k0 + 8 * c) = o; }
    lds_wait();
}
__device__ __forceinline__ void phase0(const Params& p, unsigned char* lds) {
    const int tid = threadIdx.x, lane = tid & 63, wv = tid >> 6, fr = lane & 15, fq = lane >> 4;
    float* rowss = (float*)(p.ws + OFF_ROWSS);
    for (int i = blockIdx.x * 512 + tid; i < T; i += gridDim.x * 512) rowss[i] = 0.f;
    for (int d = tid; d < D; d += 512) {
        const float* src = p.w_in + (size_t)d * DIN + 8192; float v[16];
#pragma unroll
        for (int i = 0; i < 4; ++i) { const f32x4 t = *(const f32x4*)(src + 4 * i); v[4 * i] = t[0]; v[4 * i + 1] = t[1]; v[4 * i + 2] = t[2]; v[4 * i + 3] = t[3]; }
        const int kb = d >> 5, q = (d & 31) >> 3, e = d & 7;
#pragma unroll
        for (int g = 0; g < 16; ++g) *(unsigned short*)(lds + kb * 1024 + (q * 16 + g) * 16 + e * 2) = (unsigned short)(cvt_pk_bf16(v[g], 0.f) & 0xffffu);
    }
    __syncthreads();
    bf16_t* xs = (bf16_t*)p.out; float* GI = (float*)(p.ws + OFF_GI); float* GF = (float*)(p.ws + OFF_GF);
    for (int wt = blockIdx.x * 8 + wv; wt < T / 16; wt += gridDim.x * 8) {
        const int r0 = wt * 16;
        f32x4 nw[8];
#pragma unroll
        for (int j = 0; j < 8; ++j) nw[j] = *(const f32x4*)(p.norm_w + 4 * lane + 256 * j);
#pragma unroll 4
        for (int r = 0; r < 16; ++r) {
            const float* xr = p.x + (size_t)(r0 + r) * D + 4 * lane; f32x4 v[8]; float ss = 0.f;
#pragma unroll
            for (int j = 0; j < 8; ++j) v[j] = *(const f32x4*)(xr + 256 * j);
#pragma unroll
            for (int j = 0; j < 8; ++j) ss += (v[j][0] * v[j][0] + v[j][1] * v[j][1]) + (v[j][2] * v[j][2] + v[j][3] * v[j][3]);
#pragma unroll
            for (int o = 1; o < 64; o <<= 1) ss += __shfl_xor(ss, o);
            const float rs = 1.0f / sqrtf(ss * (1.0f / D) + 1e-6f);
            bf16_t* orow = xs + (size_t)(r0 + r) * D + 4 * lane;
#pragma unroll
            for (int j = 0; j < 8; ++j) { const f32x4 o4 = v[j] * rs * nw[j]; u32x2 pk; pk.x = cvt_pk_bf16(o4[0], o4[1]); pk.y = cvt_pk_bf16(o4[2], o4[3]); *(u32x2*)(orow + 256 * j) = pk; }
        }
        __builtin_amdgcn_fence(__ATOMIC_RELEASE, "workgroup"); asm volatile("s_waitcnt vmcnt(0)" ::: "memory"); __builtin_amdgcn_fence(__ATOMIC_ACQUIRE, "workgroup");
        const int row = r0 + fr; const bf16_t* xsr = xs + (size_t)row * D + fq * 8;
        f32x4 acc = (f32x4){0.f, 0.f, 0.f, 0.f};
#pragma unroll 16
        for (int kb = 0; kb < 64; ++kb) { const bf16x8 Y = *(const bf16x8*)(xsr + kb * 32); const bf16x8 X = *(const bf16x8*)(lds + kb * 1024 + lane * 16); acc = mma(X, Y, acc); }
        const int b = row >> 14, s = row & (SEQ - 1);
#pragma unroll
        for (int j = 0; j < 4; ++j) { const int g = 4 * fq + j; const float v = acc[j];
            if (g < 8) GI[(size_t)(b * 8 + g) * SEQ + s] = v + p.b_i[g];
            else { const float z = v + p.b_f[g - 8]; GF[(size_t)(b * 8 + g - 8) * SEQ + s] = fminf(z, 0.f) - log1pf(__expf(-fabsf(z))); } }
    }
    __syncthreads();
    float* scr = (float*)(lds + wv * 16640);
    bf16_t* Bt1 = (bf16_t*)((unsigned char*)p.out + OUT_OFF_BT1); bf16_t* Bt2 = (bf16_t*)(p.ws + OFF_BT2);
    constexpr int NIT1 = 32 * 224, NIT2 = 64 * 32;
    for (int it = blockIdx.x * 8 + wv; it < NIT1 + NIT2; it += gridDim.x * 8) {
        if (it < NIT1) { const int kb = it / 224, nb = it % 224; transpose_item(p.w_in, DIN, srcmap(64 * nb), 64 * kb, Bt1, D, 64 * nb, scr, lane); }
        else { const int r = it - NIT1, kb = r >> 5, nb = r & 31; transpose_item(p.w_out, D, 64 * nb, 64 * kb, Bt2, 4096, 64 * nb, scr, lane); }
    }
}

__device__ __forceinline__ void gate_prep(const Params& p) {
    const int tid = threadIdx.x, lane = tid & 63, wv = tid >> 6;
    for (int u = blockIdx.x * 8 + wv; u < NU; u += gridDim.x * 8) {
        const int h = u & 7, n = (u >> 3) & 127, b = u >> 10; const size_t base = (size_t)(b * 8 + h) * SEQ + n * 128 + 2 * lane;
        const f32x2 i2 = *(const f32x2*)((const float*)(p.ws + OFF_GI) + base), f2 = *(const f32x2*)((const float*)(p.ws + OFF_GF) + base);
        const float pr = f2.x + f2.y, inc = wave_scan_add(pr, lane), exc = inc - pr, b0 = exc + f2.x, b1 = inc, bL = __shfl(inc, 63);
        const float wl0 = bL - b0 + i2.x, wl1 = bL - b1 + i2.y, ml = wave_max(fmaxf(wl0, wl1));
        const float g0 = i2.x - b0, g1 = i2.y - b1; const float incm = wave_scan_max(fmaxf(g0, g1), lane); float excm = __shfl_up(incm, 1); if (lane == 0) excm = -3.0e38f;
        *(f32x2*)((float*)(p.ws + OFF_WSV) + base) = (f32x2){fexp(wl0 - ml), fexp(wl1 - ml)};
        *(f32x2*)((float*)(p.ws + OFF_GS) + base) = (f32x2){g0, g1};
        *(f32x2*)((float*)(p.ws + OFF_BT) + base) = (f32x2){b0, b1};
        *(f32x2*)((float*)(p.ws + OFF_CM) + base) = (f32x2){fmaxf(excm, g0), incm};
        if (lane == 0) { ((float*)(p.ws + OFF_BL))[u] = bL; ((float*)(p.ws + OFF_MLOC))[u] = ml; }
    }
}
__device__ __forceinline__ void conv_load(const bf16_t* src, int s, bool first, u32x4 (&raw)[7]) {
#pragma unroll
    for (int i = 0; i < 7; ++i) { const int r = s - 3 + i; raw[i] = (u32x4){0u, 0u, 0u, 0u}; if (!(first && r < 0)) raw[i] = *(const u32x4*)(src + (ptrdiff_t)r * LDP); }
}
__device__ __forceinline__ void conv_tab_load(const Params& p, float* tab, int h, int which) {
    for (int i = threadIdx.x; i < 640; i += 512) { const int j = i >> 7, c = i & 127; tab[i] = (j < 4) ? p.conv_w[j * 2048 + which * 1024 + h * 128 + c] : p.conv_b[which * 1024 + h * 128 + c]; }
}
__device__ __forceinline__ void conv_silu(const u32x4 (&raw)[7], const float* tabc, float scale, float (&y)[4][8]) {
    float xin[7][8];
#pragma unroll
    for (int i = 0; i < 7; ++i) { const u32x4 w = raw[i];
        xin[i][0] = bf_lo(w.x); xin[i][1] = bf_hi(w.x); xin[i][2] = bf_lo(w.y); xin[i][3] = bf_hi(w.y); xin[i][4] = bf_lo(w.z); xin[i][5] = bf_hi(w.z); xin[i][6] = bf_lo(w.w); xin[i][7] = bf_hi(w.w); }
#pragma unroll
    for (int hf = 0; hf < 2; ++hf) { f32x4 acc[4]; const f32x4 bias = *(const f32x4*)(tabc + 512 + 4 * hf);
#pragma unroll
        for (int r = 0; r < 4; ++r) acc[r] = bias;
#pragma unroll
        for (int j = 0; j < 4; ++j) { const f32x4 w = *(const f32x4*)(tabc + j * 128 + 4 * hf);
#pragma unroll
            for (int r = 0; r < 4; ++r)
#pragma unroll
                for (int e = 0; e < 4; ++e) acc[r][e] += w[e] * xin[r + j][4 * hf + e]; }
#pragma unroll
        for (int r = 0; r < 4; ++r)
#pragma unroll
            for (int e = 0; e < 4; ++e) { const float v = acc[r][e]; y[r][4 * hf + e] = scale * v * frcp(1.0f + fexp(-v)); } }
}
__device__ __forceinline__ void write_T8(unsigned char* tile, int R, int c0, int s0, const u32x4 (&w)[8]) {
#pragma unroll
    for (int e = 0; e < 8; ++e) { u32x4 o;
#pragma unroll
        for (int q = 0; q < 4; ++q) { const unsigned a = w[2 * q][e >> 1], b = w[2 * q + 1][e >> 1]; o[q] = (e & 1) ? ((a >> 16) | (b & 0xffff0000u)) : ((a & 0xffffu) | (b << 16)); }
        *(u32x4*)(tile + tile_off(R, c0 + e, s0)) = o; }
}

constexpr int P2_CT = 102400;
__device__ __forceinline__ void mlstm_pass1(const Params& p, unsigned char* lds, int u) {
    const int tid = threadIdx.x, lane = tid & 63, wv = tid >> 6, fr = lane & 15, fq = lane >> 4;
    const int h = u & 7, n = (u >> 3) & 127, b = u >> 10; const int row0 = b * SEQ + n * 128;
    unsigned char* kwT = lds; unsigned char* vT = lds + 32768;
    const bf16_t* P = (const bf16_t*)(p.ws + OFF_P);
    const int cgv = (lane & 7) + 8 * (wv >> 1), rgv = (lane >> 3) + 8 * (wv & 1), cgk = tid & 15, rgk = tid >> 4;
    u32x4 vr[8];
    { const bf16_t* src = P + (size_t)(row0 + 8 * rgv) * LDP + 2048 + h * 256 + 8 * cgv;
#pragma unroll
        for (int i = 0; i < 8; ++i) vr[i] = *(const u32x4*)(src + (size_t)i * LDP); }
    u32x4 kr[7]; conv_load(P + (size_t)row0 * LDP + 1024 + h * 128 + 8 * cgk, 4 * rgk, n == 0, kr);
    const f32x4 wq = *(const f32x4*)((const float*)(p.ws + OFF_WSV) + (size_t)(b * 8 + h) * SEQ + n * 128 + 4 * rgk);
    write_T8(vT, 272, 8 * cgv, 8 * rgv, vr);
    if (tid < 16) { const unsigned one2 = 0x3f803f80u; *(u32x4*)(vT + tile_off(272, 256, 8 * tid)) = (u32x4){one2, one2, one2, one2}; }
    else if (tid < 256) { const int pc = tid - 16; *(u32x4*)(vT + tile_off(272, 257 + (pc >> 4), 8 * (pc & 15))) = (u32x4){0u, 0u, 0u, 0u}; }
    { float y[4][8]; conv_silu(kr, (const float*)(lds + P2_CT) + 8 * cgk, 0.08838834764831845f, y);
#pragma unroll
        for (int e = 0; e < 8; ++e) { u32x2 o; o.x = cvt_pk_bf16(y[0][e] * wq[0], y[1][e] * wq[1]); o.y = cvt_pk_bf16(y[2][e] * wq[2], y[3][e] * wq[3]);
            *(u32x2*)(kwT + tile_off(128, 8 * cgk + e, 4 * rgk)) = o; } }
    __syncthreads();
    bf16x8 Yk[4];
#pragma unroll
    for (int kb = 0; kb < 4; ++kb) Yk[kb] = *(const bf16x8*)(kwT + tile_off(128, 16 * wv + fr, 32 * kb + 8 * fq));
    float* dC = (float*)p.out + (size_t)u * 32768; float* dn = (float*)(p.ws + OFF_DN) + (size_t)u * 128;
#pragma unroll
    for (int nb = 0; nb < 17; ++nb) { f32x4 acc = (f32x4){0.f, 0.f, 0.f, 0.f};
#pragma unroll
        for (int kb = 0; kb < 4; ++kb) { const bf16x8 X = *(const bf16x8*)(vT + tile_off(272, 16 * nb + fr, 32 * kb + 8 * fq)); acc = mma(X, Yk[kb], acc); }
        if (nb < 16) {
#pragma unroll
            for (int j = 0; j < 4; ++j) dC[(16 * nb + 4 * fq + j) * 128 + 16 * wv + fr] = acc[j];
        } else if (fq == 0) dn[16 * wv + fr] = acc[0]; }
    __syncthreads();
}

__device__ __forceinline__ void gmlp_unit(const Params& p, unsigned char* lds, int u, bool dry) {
    const int tid = threadIdx.x, lane = tid & 63, wv = tid >> 6, fr = lane & 15, fq = lane >> 4;
    const int h = u & 7, n = (u >> 3) & 127, b = u >> 10; const int row0 = b * SEQ + n * 128;
    bf16_t* P = (bf16_t*)(p.ws + OFF_P); unsigned char* vT = lds;
    const int cg = tid & 31, rg = tid >> 5, t = 16 * wv + fr, wlim = wv >> 1;
    u32x4 raw[8];
    { const bf16_t* src = P + (size_t)(row0 + 8 * rg) * LDP + 8192 + h * 256 + 8 * cg;
#pragma unroll
        for (int i = 0; i < 8; ++i) raw[i] = *(const u32x4*)(src + (size_t)i * LDP); }
    const f32x4 lw0 = *(const f32x4*)(p.sgu_w + h * 256 + 8 * cg), lw1 = *(const f32x4*)(p.sgu_w + h * 256 + 8 * cg + 4);
    const f32x4 lb0 = *(const f32x4*)(p.sgu_b + h * 256 + 8 * cg), lb1 = *(const f32x4*)(p.sgu_b + h * 256 + 8 * cg + 4);
    f32x4 wsp[4][2];
    { const float* wr = p.w_sp + (size_t)h * 16384 + (size_t)t * 128 + 8 * fq;
#pragma unroll
        for (int kb = 0; kb < 4; ++kb) { wsp[kb][0] = (f32x4){0.f, 0.f, 0.f, 0.f}; wsp[kb][1] = wsp[kb][0]; if (kb <= wlim) { wsp[kb][0] = *(const f32x4*)(wr + 32 * kb); wsp[kb][1] = *(const f32x4*)(wr + 32 * kb + 4); } } }
    const float bsp = p.b_sp[h * 128 + t];
    bf16_t* gp = P + (size_t)(row0 + t) * LDP + 6144 + h * 256 + 4 * fq;
    u32x2 gu[16];
#pragma unroll
    for (int nb = 0; nb < 16; ++nb) gu[nb] = *(const u32x2*)(gp + 16 * nb);
    { u32x4 w[8];
#pragma unroll
        for (int i = 0; i < 8; ++i) { float v[8]; const u32x4 tt = raw[i];
            v[0] = bf_lo(tt.x); v[1] = bf_hi(tt.x); v[2] = bf_lo(tt.y); v[3] = bf_hi(tt.y); v[4] = bf_lo(tt.z); v[5] = bf_hi(tt.z); v[6] = bf_lo(tt.w); v[7] = bf_hi(tt.w);
            float s = 0.f;
#pragma unroll
            for (int e = 0; e < 8; ++e) s += v[e];
#pragma unroll
            for (int o = 1; o < 32; o <<= 1) s += __shfl_xor(s, o);
            const float mu = s * (1.0f / 256.0f); float q = 0.f;
#pragma unroll
            for (int e = 0; e < 8; ++e) { v[e] -= mu; q += v[e] * v[e]; }
#pragma unroll
            for (int o = 1; o < 32; o <<= 1) q += __shfl_xor(q, o);
            const float rs = 1.0f / sqrtf(q * (1.0f / 256.0f) + 1e-6f);
            w[i].x = cvt_pk_bf16(v[0] * rs * lw0[0] + lb0[0], v[1] * rs * lw0[1] + lb0[1]); w[i].y = cvt_pk_bf16(v[2] * rs * lw0[2] + lb0[2], v[3] * rs * lw0[3] + lb0[3]);
            w[i].z = cvt_pk_bf16(v[4] * rs * lw1[0] + lb1[0], v[5] * rs * lw1[1] + lb1[1]); w[i].w = cvt_pk_bf16(v[6] * rs * lw1[2] + lb1[2], v[7] * rs * lw1[3] + lb1[3]); }
        write_T8(vT, 256, 8 * cg, 8 * rg, w); }
    bf16x8 Yw[4];
#pragma unroll
    for (int kb = 0; kb < 4; ++kb) { const int s0 = 32 * kb + 8 * fq; float f[8] = {wsp[kb][0][0], wsp[kb][0][1], wsp[kb][0][2], wsp[kb][0][3], wsp[kb][1][0], wsp[kb][1][1], wsp[kb][1][2], wsp[kb][1][3]};
#pragma unroll
        for (int e = 0; e < 8; ++e) if (s0 + e > t) f[e] = 0.f;
        u32x4 pk; pk.x = cvt_pk_bf16(f[0], f[1]); pk.y = cvt_pk_bf16(f[2], f[3]); pk.z = cvt_pk_bf16(f[4], f[5]); pk.w = cvt_pk_bf16(f[6], f[7]);
        __builtin_memcpy(&Yw[kb], &pk, 16); }
    __syncthreads();
#pragma unroll
    for (int nb = 0; nb < 16; ++nb) { f32x4 acc = (f32x4){0.f, 0.f, 0.f, 0.f};
#pragma unroll
        for (int kb = 0; kb < 4; ++kb) if (kb <= wlim) { const bf16x8 X = *(const bf16x8*)(vT + tile_off(256, 16 * nb + fr, 32 * kb + 8 * fq)); acc = mma(X, Yw[kb], acc); }
        const u32x2 g = gu[nb];
        u32x2 o; o.x = cvt_pk_bf16(bf_lo(g.x) * (acc[0] + bsp), bf_hi(g.x) * (acc[1] + bsp)); o.y = cvt_pk_bf16(bf_lo(g.y) * (acc[2] + bsp), bf_hi(g.y) * (acc[3] + bsp));
        if (!dry) *(u32x2*)(gp + 16 * nb) = o; }
    __syncthreads();
}

__device__ __forceinline__ void scan_slab(const Params& p, unsigned char* lds, int g) {
    const int tid = threadIdx.x; const int bh = g >> 4, slab = g & 15, b = bh >> 3, h = bh & 7;
    const float* dC = (const float*)p.out; bf16_t* Cst = (bf16_t*)(p.ws + OFF_CST);
    const float* dn = (const float*)(p.ws + OFF_DN); bf16_t* nstb = (bf16_t*)(p.ws + OFF_NSTB);
    const float* bLa = (const float*)(p.ws + OFF_BL); const float* mla = (const float*)(p.ws + OFF_MLOC); float* mst = (float*)(p.ws + OFF_MST);
    const size_t off = (size_t)slab * 2048 + 4 * tid; const bool don = (slab == 0 && tid < 32);
    const int u0 = (b * 128) * 8 + h;
    f32x4 d[8], e[8];
#pragma unroll
    for (int j = 0; j < 8; ++j) { d[j] = *(const f32x4*)(dC + (size_t)(u0 + 8 * j) * 32768 + off); e[j] = don ? *(const f32x4*)(dn + (size_t)(u0 + 8 * j) * 128 + 4 * tid) : (f32x4){0.f, 0.f, 0.f, 0.f}; }
    float* sc = (float*)lds;
    __syncthreads();
    if (tid < 128) { sc[2 * tid] = bLa[u0 + 8 * tid]; sc[2 * tid + 1] = mla[u0 + 8 * tid]; }
    __syncthreads();
    if (tid == 0) { float m = 0.f;
        for (int n = 0; n < 128; ++n) { const float bL = sc[2 * n], ml = sc[2 * n + 1]; if (slab == 0) mst[u0 + 8 * n] = m;
            const float mn = fmaxf(bL + m, ml); sc[2 * n] = fexp(bL + m - mn); sc[2 * n + 1] = fexp(ml - mn); m = mn; } }
    __syncthreads();
    f32x4 C = (f32x4){0.f, 0.f, 0.f, 0.f}, nv = (f32x4){0.f, 0.f, 0.f, 0.f};
    for (int n0 = 0; n0 < 128; n0 += 8) {
#pragma unroll
        for (int j = 0; j < 8; ++j) { const int n = n0 + j, u = u0 + 8 * n;
            u32x2 o; o.x = cvt_pk_bf16(C[0], C[1]); o.y = cvt_pk_bf16(C[2], C[3]); *(u32x2*)(Cst + (size_t)u * 32768 + off) = o;
            if (don) { u32x2 q; q.x = cvt_pk_bf16(nv[0], nv[1]); q.y = cvt_pk_bf16(nv[2], nv[3]); *(u32x2*)(nstb + (size_t)u * 128 + 4 * tid) = q; }
            const f32x2 as = *(const f32x2*)(sc + 2 * n);
            C = as.x * C + as.y * d[j]; nv = as.x * nv + as.y * e[j];
            if (n + 8 < 128) { d[j] = *(const f32x4*)(dC + (size_t)(u + 64) * 32768 + off); if (don) e[j] = *(const f32x4*)(dn + (size_t)(u + 64) * 128 + 4 * tid); } }
    }
}

constexpr int P4_GS = 135168, P4_NV = P4_GS + 512, P4_NW = P4_GS + 1024, P4_CQ = P4_NW + 1024, P4_CK = P4_CQ + 2560;
__device__ __forceinline__ void mlstm_pass3(const Params& p, unsigned char* lds, int u, bool dry) {
    const int tid = threadIdx.x, lane = tid & 63, wv = tid >> 6, fr = lane & 15, fq = lane >> 4;
    const int h = u & 7, n = (u >> 3) & 127, b = u >> 10; const int row0 = b * SEQ + n * 128;
    unsigned char* Qt = lds; unsigned char* Kt = lds + 32768; unsigned char* vT = lds + 65536; unsigned char* CTt = lds;
    float* gsl = (float*)(lds + P4_GS); unsigned char* nvl = lds + P4_NV; const float* nwl = (const float*)(lds + P4_NW);
    bf16_t* P = (bf16_t*)(p.ws + OFF_P);
    const size_t gbase = (size_t)(b * 8 + h) * SEQ + n * 128; const int t = 16 * wv + fr, wlim = wv >> 1;
    const int cgv = (lane & 7) + 8 * (wv >> 1), rgv = (lane >> 3) + 8 * (wv & 1), cgk = tid & 15, rgk = tid >> 4;
    u32x4 vr[8];
    { const bf16_t* src = P + (size_t)(row0 + 8 * rgv) * LDP + 2048 + h * 256 + 8 * cgv;
#pragma unroll
        for (int i = 0; i < 8; ++i) vr[i] = *(const u32x4*)(src + (size_t)i * LDP); }
    u32x4 qr[7], kr[7];
    conv_load(P + (size_t)row0 * LDP + h * 128 + 8 * cgk, 4 * rgk, n == 0, qr);
    conv_load(P + (size_t)row0 * LDP + 1024 + h * 128 + 8 * cgk, 4 * rgk, n == 0, kr);
    const float mprev = ((const float*)(p.ws + OFF_MST))[u];
    const float cmt = ((const float*)(p.ws + OFF_CM))[gbase + t], bt = ((const float*)(p.ws + OFF_BT))[gbase + t];
    float gsx = 0.f; u32x4 nvx = (u32x4){0u, 0u, 0u, 0u};
    if (tid < 128) gsx = ((const float*)(p.ws + OFF_GS))[gbase + tid];
    else if (tid < 144) nvx = *(const u32x4*)((const bf16_t*)(p.ws + OFF_NSTB) + (size_t)u * 128 + 8 * (tid - 128));
    write_T8(vT, 272, 8 * cgv, 8 * rgv, vr);
    if (tid < 16) { const unsigned one2 = 0x3f803f80u; *(u32x4*)(vT + tile_off(272, 256, 8 * tid)) = (u32x4){one2, one2, one2, one2}; }
    else if (tid < 256) { const int pc = tid - 16; *(u32x4*)(vT + tile_off(272, 257 + (pc >> 4), 8 * (pc & 15))) = (u32x4){0u, 0u, 0u, 0u}; }
    { float y[4][8]; conv_silu(qr, (const float*)(lds + P4_CQ) + 8 * cgk, 1.0f, y);
#pragma unroll
        for (int r = 0; r < 4; ++r) { u32x4 o; o.x = cvt_pk_bf16(y[r][0], y[r][1]); o.y = cvt_pk_bf16(y[r][2], y[r][3]); o.z = cvt_pk_bf16(y[r][4], y[r][5]); o.w = cvt_pk_bf16(y[r][6], y[r][7]);
            *(u32x4*)(Qt + tile_off(128, 4 * rgk + r, 8 * cgk)) = o; }
        conv_silu(kr, (const float*)(lds + P4_CK) + 8 * cgk, 0.08838834764831845f, y);
#pragma unroll
        for (int r = 0; r < 4; ++r) { u32x4 o; o.x = cvt_pk_bf16(y[r][0], y[r][1]); o.y = cvt_pk_bf16(y[r][2], y[r][3]); o.z = cvt_pk_bf16(y[r][4], y[r][5]); o.w = cvt_pk_bf16(y[r][6], y[r][7]);
            *(u32x4*)(Kt + tile_off(128, 4 * rgk + r, 8 * cgk)) = o; } }
    if (tid < 128) gsl[tid] = gsx; else if (tid < 144) *(u32x4*)(nvl + 16 * (tid - 128)) = nvx;
    u32x4 ct[8];
    { const bf16_t* CT = (const bf16_t*)(p.ws + OFF_CST) + (size_t)u * 32768;
#pragma unroll
        for (int i = 0; i < 8; ++i) { const int pi = tid + 512 * i; ct[i] = *(const u32x4*)(CT + (pi >> 4) * 128 + 8 * (pi & 15)); } }
    __syncthreads();
    bf16x8 Yq[4];
#pragma unroll
    for (int kb = 0; kb < 4; ++kb) Yq[kb] = *(const bf16x8*)(Qt + tile_off(128, t, 32 * kb + 8 * fq));
    const float Mt = fmaxf(mprev, cmt);
    bf16x8 pa[4];
#pragma unroll
    for (int kb2 = 0; kb2 < 4; ++kb2) { u32x4 pk = (u32x4){0u, 0u, 0u, 0u};
        if (kb2 <= wlim) { float sv[8];
#pragma unroll
            for (int hb = 0; hb < 2; ++hb) { f32x4 acc = (f32x4){0.f, 0.f, 0.f, 0.f}; const int srow = 32 * kb2 + 8 * (fr >> 2) + 4 * hb + (fr & 3);
#pragma unroll
                for (int kb = 0; kb < 4; ++kb) { const bf16x8 X = *(const bf16x8*)(Kt + tile_off(128, srow, 32 * kb + 8 * fq)); acc = mma(X, Yq[kb], acc); }
                const int s0 = 32 * kb2 + 8 * fq + 4 * hb; const f32x4 g4 = *(const f32x4*)(gsl + s0);
#pragma unroll
                for (int j = 0; j < 4; ++j) sv[4 * hb + j] = (s0 + j <= t) ? acc[j] * fexp(g4[j] - Mt) : 0.f; }
            pk.x = cvt_pk_bf16(sv[0], sv[1]); pk.y = cvt_pk_bf16(sv[2], sv[3]); pk.z = cvt_pk_bf16(sv[4], sv[5]); pk.w = cvt_pk_bf16(sv[6], sv[7]); }
        __builtin_memcpy(&pa[kb2], &pk, 16); }
    __syncthreads();
#pragma unroll
    for (int i = 0; i < 8; ++i) { const int pi = tid + 512 * i; *(u32x4*)(CTt + tile_off(256, pi >> 4, 8 * (pi & 15))) = ct[i]; }
    bf16_t* gp = P + (size_t)(row0 + t) * LDP + 4096 + h * 256 + 4 * fq;
    u32x2 gm[16];
#pragma unroll
    for (int nb = 0; nb < 16; ++nb) gm[nb] = *(const u32x2*)(gp + 16 * nb);
    __syncthreads();
    const float decay = fexp(mprev - Mt);
    f32x4 o[17];
#pragma unroll
    for (int nb = 0; nb < 17; ++nb) { f32x4 acc = (f32x4){0.f, 0.f, 0.f, 0.f};
#pragma unroll
        for (int kb = 0; kb < 4; ++kb) { bf16x8 X;
            if (nb < 16) X = *(const bf16x8*)(CTt + tile_off(256, 16 * nb + fr, 32 * kb + 8 * fq));
            else { u32x4 z = (u32x4){0u, 0u, 0u, 0u}; if (fr == 0) z = *(const u32x4*)(nvl + 64 * kb + 16 * fq); __builtin_memcpy(&X, &z, 16); }
            acc = mma(X, Yq[kb], acc); }
        acc *= decay;
#pragma unroll
        for (int kb2 = 0; kb2 < 4; ++kb2) if (kb2 <= wlim) { const bf16x8 X = *(const bf16x8*)(vT + tile_off(272, 16 * nb + fr, 32 * kb2 + 8 * fq)); acc = mma(X, pa[kb2], acc); }
        o[nb] = acc; }
    const float den = __shfl(o[16][0], fr);
    const float inv = frcp(fmaxf(fabsf(den), fexp(-(bt + Mt))));
    float ss = 0.f;
#pragma unroll
    for (int nb = 0; nb < 16; ++nb) { o[nb] *= inv; ss += (o[nb][0] * o[nb][0] + o[nb][1] * o[nb][1]) + (o[nb][2] * o[nb][2] + o[nb][3] * o[nb][3]); }
    ss += __shfl_xor(ss, 16); ss += __shfl_xor(ss, 32);
    const float rn = 1.0f / sqrtf(ss * (1.0f / 256.0f) + 1e-6f);
    const float* nw = nwl + 4 * fq;
#pragma unroll
    for (int nb = 0; nb < 16; ++nb) { const u32x2 g = gm[nb]; const f32x4 w4 = *(const f32x4*)(nw + 16 * nb);
        u32x2 q; q.x = cvt_pk_bf16(o[nb][0] * rn * w4[0] * bf_lo(g.x), o[nb][1] * rn * w4[1] * bf_hi(g.x)); q.y = cvt_pk_bf16(o[nb][2] * rn * w4[2] * bf_lo(g.y), o[nb][3] * rn * w4[3] * bf_hi(g.y));
        if (!dry) *(u32x2*)(gp + 16 * nb) = q; }
    __syncthreads();
}

__device__ __forceinline__ void final_norm(const Params& p, bool dry) {
    const int tid = threadIdx.x, lane = tid & 63, wv = tid >> 6; const float* rowss = (const float*)(p.ws + OFF_ROWSS);
    for (int row = blockIdx.x * 8 + wv; row < T; row += gridDim.x * 8) {
        const float rs = 1.0f / sqrtf(rowss[row] * (1.0f / D) + 1e-6f); float* rp = p.out + (size_t)row * D + 4 * lane;
#pragma unroll
        for (int j = 0; j < 8; ++j) { const f32x4 v = *(const f32x4*)(rp + 256 * j); const f32x4 w = *(const f32x4*)(p.fnorm_w + 4 * lane + 256 * j); if (!dry) *(f32x4*)(rp + 256 * j) = v * rs * w; }
    }
}

#ifndef HY_REP
#define HY_REP 0
#endif
#ifndef HY_SKIP
#define HY_SKIP 0
#endif
struct DryOrder : pg8::StaticOrder {
    __device__ bool next(int i, pg8::Unit& u) const { const bool r = pg8::StaticOrder::next(i, u); u.pm = (c >> 3) & 1; u.pn = c & 1; return r; }
};
__device__ __forceinline__ void run_gemm1(const Params& p, unsigned char* smem, bool plain) {
    gate_prep(p);
    pg8::Gemm g; g.A = (const bf16_t*)p.out; g.Bt = (const bf16_t*)((const unsigned char*)p.out + OUT_OFF_BT1); g.M = T; g.N = N1; g.K = D;
    Epi1 E; E.P = (bf16_t*)(p.ws + OFF_P); E.plain = plain;
#if HY_REP
    if (plain) { DryOrder S; S.init(T, N1, gridDim.x, blockIdx.x); pg8::gemm_phase<Epi1, DryOrder, true, true>((PG8_LAS unsigned char*)smem, g, D, S, E); return; }
#endif
    pg8::StaticOrder S; S.init(T, N1, gridDim.x, blockIdx.x);
    pg8::gemm_phase<Epi1, pg8::StaticOrder, true, true>((PG8_LAS unsigned char*)smem, g, D, S, E);
}
__device__ __forceinline__ void run_gemm2(const Params& p, unsigned char* smem, bool dry) {
    pg8::Gemm g; g.A = (const bf16_t*)(p.ws + OFF_P) + 4096; g.Bt = (const bf16_t*)(p.ws + OFF_BT2); g.M = T; g.N = D; g.K = 4096;
    pg8::StaticOrder S; S.init(T, D, gridDim.x, blockIdx.x);
    Epi2 E; E.x = p.x; E.hout = p.out; E.rowss = (float*)(p.ws + OFF_ROWSS); E.dry = dry;
    pg8::gemm_phase<Epi2, pg8::StaticOrder, true, true>((PG8_LAS unsigned char*)smem, g, LDP, S, E);
}
__device__ __forceinline__ void run_p2(const Params& p, unsigned char* smem, bool dry) {
    int hl = -1;
    for (int it = blockIdx.x; it < 2 * NU; it += gridDim.x) {
        if (it < NU) { const int h = it & 7; if (h != hl) { __syncthreads(); conv_tab_load(p, (float*)(smem + P2_CT), h, 1); __syncthreads(); hl = h; } mlstm_pass1(p, smem, it); }
        else gmlp_unit(p, smem, it - NU, dry); }
}
__device__ __forceinline__ void run_p3(const Params& p, unsigned char* smem) { for (int g = blockIdx.x; g < 256; g += gridDim.x) scan_slab(p, smem, g); }
__device__ __forceinline__ void run_p4(const Params& p, unsigned char* smem, bool dry) {
    int hl = -1;
    for (int it = blockIdx.x; it < NU; it += gridDim.x) {
        const int h = it & 7;
        if (h != hl) { __syncthreads(); conv_tab_load(p, (float*)(smem + P4_CQ), h, 0); conv_tab_load(p, (float*)(smem + P4_CK), h, 1);
            for (int i = threadIdx.x; i < 256; i += 512) ((float*)(smem + P4_NW))[i] = p.mnorm_w[h * 256 + i];
            __syncthreads(); hl = h; }
        mlstm_pass3(p, smem, it, dry); }
}
__global__ void __launch_bounds__(512) hymba_fwd(Params p, int rep) {
    extern __shared__ __attribute__((aligned(16))) unsigned char smem[];
    cgx::grid_group grid = cgx::this_grid();
#if HY_REP
    if (rep & 1) { phase0(p, smem); grid.sync(); }
#endif
    if (!((HY_SKIP >> 0) & 1)) {
    phase0(p, smem); }
    grid.sync();
#if HY_REP
    if (rep & 2) { run_gemm1(p, smem, true); grid.sync(); }
#endif
    if (!((HY_SKIP >> 1) & 1)) {
    run_gemm1(p, smem, false); }
    grid.sync();
#if HY_REP
    if (rep & 4) { run_p2(p, smem, true); grid.sync(); }
#endif
    if (!((HY_SKIP >> 2) & 1)) {
    run_p2(p, smem, false); }
    grid.sync();
#if HY_REP
    if (rep & 8) { run_p3(p, smem); grid.sync(); }
#endif
    if (!((HY_SKIP >> 3) & 1)) {
    run_p3(p, smem); }
    grid.sync();
#if HY_REP
    if (rep & 16) { run_p4(p, smem, true); grid.sync(); }
#endif
    if (!((HY_SKIP >> 4) & 1)) {
    run_p4(p, smem, false); }
    grid.sync();
#if HY_REP
    if (rep & 32) { run_gemm2(p, smem, true); grid.sync(); }
#endif
    if (!((HY_SKIP >> 5) & 1)) {
    run_gemm2(p, smem, false); }
    grid.sync();
#if HY_REP
    if (rep & 64) { final_norm(p, true); grid.sync(); }
#endif
    final_norm(p, false);
}
}

extern "C" void kernel_launch(void* const* d_in, const int* in_sizes, int n_in, void* d_out, int out_size, void* d_ws, size_t ws_size, hipStream_t stream) {
    static int grid = 0;
    if (grid == 0) {
        if (n_in != 14 || out_size != hy::T * hy::D || ws_size < hy::WS_END) { fprintf(stderr, "kernel_launch: unexpected sizes (n_in %d out %d ws %zu need %zu)\n", n_in, out_size, ws_size, (size_t)hy::WS_END); grid = -1; return; }
        int dev = 0, cus = 0, per_cu = 0;
        (void)hipGetDevice(&dev); (void)hipDeviceGetAttribute(&cus, hipDeviceAttributeMultiprocessorCount, dev);
        if (hipFuncSetAttribute((const void*)hy::hymba_fwd, hipFuncAttributeMaxDynamicSharedMemorySize, hy::LDS_BYTES) != hipSuccess) { fprintf(stderr, "kernel_launch: hipFuncSetAttribute failed\n"); grid = -1; return; }
        if (hipOccupancyMaxActiveBlocksPerMultiprocessor(&per_cu, (const void*)hy::hymba_fwd, 512, hy::LDS_BYTES) != hipSuccess || per_cu < 1) { fprintf(stderr, "kernel_launch: occupancy query says %d\n", per_cu); per_cu = 1; }
        (void)hipGetLastError();
        grid = cus > 0 ? cus : 256;
    }
    if (grid < 0) return;
    hy::Params p{};
    p.x = (const float*)d_in[0]; p.norm_w = (const float*)d_in[1]; p.w_in = (const float*)d_in[2]; p.conv_w = (const float*)d_in[3]; p.conv_b = (const float*)d_in[4];
    p.b_i = (const float*)d_in[5]; p.b_f = (const float*)d_in[6]; p.mnorm_w = (const float*)d_in[7]; p.sgu_w = (const float*)d_in[8]; p.sgu_b = (const float*)d_in[9];
    p.w_sp = (const float*)d_in[10]; p.b_sp = (const float*)d_in[11]; p.w_out = (const float*)d_in[12]; p.fnorm_w = (const float*)d_in[13];
    p.out = (float*)d_out; p.ws = (unsigned char*)d_ws;
    int rep = HY_REP; void* args[] = {&p, &rep};
    hipError_t e = hipLaunchCooperativeKernel((const void*)hy::hymba_fwd, dim3(grid), dim3(512), args, hy::LDS_BYTES, stream);
    if (e != hipSuccess) fprintf(stderr, "cooperative launch failed: %s (grid %d)\n", hipGetErrorString(e), grid);
}
```

```cpp
#include <hip/hip_runtime.h>
#include <hip/hip_cooperative_groups.h>
#include <cstdio>
#include <cstdint>
namespace cgx = cooperative_groups;
namespace pg8 {
#define PG8_LAS __attribute__((address_space(3)))
typedef unsigned short bf16_t;
typedef short bf16x8 __attribute__((ext_vector_type(8)));
typedef float f32x4 __attribute__((ext_vector_type(4)));
typedef unsigned u32x4 __attribute__((ext_vector_type(4)));
constexpr int BM = 256, BK = 64, HALF = 128, HTB = HALF * BK * 2  , STAGE_BYTES = 8 * HTB, NXCD = 8, WGM = 4;

__host__ __device__ __forceinline__ int lds_byte(int r, int c) { const int st = (r >> 4) * 2 + (c >> 5), rr = r & 15, cc = c & 31, ob = rr * 64 + cc * 2; return st * 1024 + (ob ^ (((ob >> 9) & 1) << 5)); }
__host__ __device__ __forceinline__ void stage_rc(int b, int& R, int& C) { const int st = b / 1024, sb = b % 1024, swz = sb ^ (((sb >> 9) & 1) << 5); R = (st >> 1) * 16 + swz / 64; C = (st & 1) * 32 + (swz % 64) / 2; }
__host__ __device__ __forceinline__ int perm32(int rho) { const int n = rho >> 4, i = rho & 15; return 8 * (i >> 2) + 4 * n + (i & 3); }

struct Unit { int pm, pn; };
struct Gemm { const bf16_t* A; const bf16_t* Bt; int M, N, K; };

struct StaticOrder {
    int nM, nN, nwg, G, c;
    __host__ __device__ void init(int M, int N, int G_, int c_) { nM = M / BM; nN = N / BM; nwg = nM * nN; G = G_; c = c_; }
    __host__ __device__ bool next(int i, Unit& u) const {
        const long L = (long)i * G + c; if (L >= nwg) return false;
        int wgid = (int)L; { const int q = nwg / NXCD, r = nwg % NXCD, xcd = wgid % NXCD, off = wgid / NXCD; wgid = (xcd < r ? xcd * (q + 1) : r * (q + 1) + (xcd - r) * q) + off; }
        const int nig = WGM * nN, gid = wgid / nig, fm = gid * WGM, gsz = (nM - fm) < WGM ? (nM - fm) : WGM;
        u.pm = fm + ((wgid % nig) % gsz); u.pn = (wgid % nig) / gsz; return true;
    }
    __device__ __forceinline__ void a_ready(const Unit&) const {}
    __device__ __forceinline__ void done(const Unit&) const {}
};

__device__ __forceinline__ unsigned cvt_pk_bf16(float lo, float hi) { unsigned r; asm volatile("v_cvt_pk_bf16_f32 %0, %1, %2" : "=v"(r) : "v"(lo), "v"(hi)); return r; }

template <class Epi, class Sched, bool ALIGN_EPI = false, bool SP2 = false>
__device__ __forceinline__ void gemm_phase(PG8_LAS unsigned char* lds, const Gemm g, const int lda, const Sched& S, const Epi& E) {
    const int tid = threadIdx.x, wid = __builtin_amdgcn_readfirstlane(tid >> 6), lane = tid & 63, wr = wid >> 2, wc = wid & 3, fr = lane & 15, fq = lane >> 4;
    const int K = g.K, nt = K / BK;
    unsigned voffA[2], voffB[2];
#pragma unroll
    for (int i = 0; i < 2; ++i) { int R, C; stage_rc(tid * 16 + i * 8192, R, C); const int Rb = Epi::PERM ? ((R & ~31) + perm32(R & 31)) : R;
        voffA[i] = (unsigned)(R * lda + C) * 2u; voffB[i] = (unsigned)(Rb * K + C) * 2u; }
    const size_t kstep = (size_t)(BK * 2);
    const size_t hstep = (size_t)HALF * K * 2;
    const size_t tstep = 2 * hstep; const size_t hstepA = (size_t)HALF * lda * 2; const size_t tstepA = 2 * hstepA;
    const unsigned ldsw = (unsigned)wid * 1024u;
    const int aoff = lds_byte(wr * 64 + fr, fq * 8), boff = lds_byte(wc * 32 + fr, fq * 8);
#define PG8_SA(b, h) (((b) * 2 + (h)) * HTB)
#define PG8_SB(b, h) ((4 + (b) * 2 + (h)) * HTB)
#define PG8_STAGE(bufoff, gbase, voff) do { _Pragma("unroll") for (int _i = 0; _i < 2; ++_i) \
        __builtin_amdgcn_global_load_lds((const unsigned*)((const char*)(gbase) + (voff)[_i]), (PG8_LAS unsigned*)(lds + (bufoff) + ldsw + _i * 8192), 16, 0, 0); } while (0)
#define PG8_LDA(dst, b, h) do { _Pragma("unroll") for (int m = 0; m < 4; ++m) _Pragma("unroll") for (int k = 0; k < 2; ++k) dst[m][k] = *(const PG8_LAS bf16x8*)(lds + PG8_SA(b, h) + aoff + m * 2048 + k * 1024); } while (0)
#define PG8_LDB(dst, b, h) do { _Pragma("unroll") for (int n = 0; n < 2; ++n) _Pragma("unroll") for (int k = 0; k < 2; ++k) dst[n][k] = *(const PG8_LAS bf16x8*)(lds + PG8_SB(b, h) + boff + n * 2048 + k * 1024); } while (0)
#define PG8_MMA(ai, bj, At, Bt) do { __builtin_amdgcn_s_setprio(1); _Pragma("unroll") for (int m = 0; m < 4; ++m) _Pragma("unroll") for (int n = 0; n < 2; ++n) _Pragma("unroll") for (int k = 0; k < 2; ++k) \
        acc[ai][bj][m][n] = __builtin_amdgcn_mfma_f32_16x16x32_bf16(Bt[n][k], At[m][k], acc[ai][bj][m][n], 0, 0, 0); __builtin_amdgcn_s_setprio(0); } while (0)
#define PG8_WAIT_V(n) asm volatile("s_waitcnt vmcnt(" #n ")" ::: "memory")
#define PG8_WAIT_L(n) asm volatile("s_waitcnt lgkmcnt(" #n ")" ::: "memory")
#define PG8_BAR __builtin_amdgcn_s_barrier()
#define PG8_SCHED __builtin_amdgcn_sched_barrier(0)
    Unit cur, nxt; int ui = 0;
    if (!S.next(0, cur)) return;
    f32x4 acc[2][2][4][2];
#pragma unroll
    for (int a = 0; a < 2; ++a)
#pragma unroll
        for (int b = 0; b < 2; ++b)
#pragma unroll
            for (int m = 0; m < 4; ++m)
#pragma unroll
                for (int n = 0; n < 2; ++n) acc[a][b][m][n] = (f32x4){0.f, 0.f, 0.f, 0.f};
    bf16x8 At[4][2], B0[2][2], B1[2][2];
    const char* cA = (const char*)g.A + (size_t)cur.pm * tstepA; const char* cB = (const char*)g.Bt + (size_t)cur.pn * tstep;
    S.a_ready(cur);
    if constexpr (SP2) {
        PG8_STAGE(PG8_SB(0, 0), cB, voffB); PG8_STAGE(PG8_SB(0, 1), cB + hstep, voffB); PG8_STAGE(PG8_SA(0, 0), cA, voffA); PG8_STAGE(PG8_SA(0, 1), cA + hstepA, voffA);
        if (wr == 1) PG8_BAR;
        PG8_WAIT_V(2); PG8_BAR;
        PG8_STAGE(PG8_SB(1, 0), cB + kstep, voffB); PG8_STAGE(PG8_SA(1, 0), cA + kstep, voffA); PG8_STAGE(PG8_SB(1, 1), cB + hstep + kstep, voffB);
        PG8_WAIT_V(6); PG8_BAR;
    } else {
        PG8_STAGE(PG8_SB(0, 0), cB, voffB); PG8_STAGE(PG8_SA(0, 0), cA, voffA); PG8_STAGE(PG8_SB(0, 1), cB + hstep, voffB); PG8_STAGE(PG8_SA(0, 1), cA + hstepA, voffA);
        if (wr == 1) PG8_BAR;
        PG8_WAIT_V(4); PG8_BAR;
        PG8_STAGE(PG8_SB(1, 0), cB + kstep, voffB); PG8_STAGE(PG8_SA(1, 0), cA + kstep, voffA); PG8_STAGE(PG8_SB(1, 1), cB + hstep + kstep, voffB);
        PG8_WAIT_V(6); PG8_BAR;
    }
    for (;;) {
        const bool has_next = S.next(ui + 1, nxt);
        const char* nA = has_next ? (const char*)g.A + (size_t)nxt.pm * tstepA : cA; const char* nB = has_next ? (const char*)g.Bt + (size_t)nxt.pn * tstep : cB;
        for (int t = 0; t < nt; t += 2) {
            const bool last = (t == nt - 2);
            const char* a1 = cA + (size_t)(t + 1) * kstep;
            const char* a2 = last ? nA : cA + (size_t)(t + 2) * kstep; const char* b2 = last ? nB : cB + (size_t)(t + 2) * kstep;
            const char* a3 = a2 + kstep; const char* b3 = b2 + kstep;
            if (last && has_next) S.a_ready(nxt);
            if constexpr (SP2) {
            PG8_LDB(B0, 0, 0); PG8_LDB(B1, 0, 1); PG8_SCHED; PG8_LDA(At, 0, 0); PG8_STAGE(PG8_SA(1, 1), a1 + hstepA, voffA);
            PG8_WAIT_V(8); PG8_WAIT_L(0); PG8_BAR; PG8_MMA(0, 0, At, B0); PG8_MMA(0, 1, At, B1); PG8_BAR; PG8_SCHED;
            PG8_LDA(At, 0, 1); PG8_STAGE(PG8_SB(0, 0), b2, voffB); PG8_STAGE(PG8_SB(0, 1), b2 + hstep, voffB); PG8_STAGE(PG8_SA(0, 0), a2, voffA);
            PG8_WAIT_V(8); PG8_WAIT_L(0); PG8_BAR; PG8_MMA(1, 0, At, B0); PG8_MMA(1, 1, At, B1); PG8_BAR; PG8_SCHED;
            PG8_LDB(B0, 1, 0); PG8_LDB(B1, 1, 1); PG8_SCHED; PG8_LDA(At, 1, 0); PG8_STAGE(PG8_SA(0, 1), a2 + hstepA, voffA);
            PG8_WAIT_V(8); PG8_WAIT_L(0); PG8_BAR; PG8_MMA(0, 0, At, B0); PG8_MMA(0, 1, At, B1); PG8_BAR; PG8_SCHED;
            PG8_LDA(At, 1, 1); PG8_STAGE(PG8_SB(1, 0), b3, voffB); PG8_STAGE(PG8_SB(1, 1), b3 + hstep, voffB); PG8_STAGE(PG8_SA(1, 0), a3, voffA);
            PG8_WAIT_V(8); PG8_WAIT_L(0); PG8_BAR; PG8_MMA(1, 0, At, B0); PG8_MMA(1, 1, At, B1); PG8_BAR; PG8_SCHED;
            } else {
            PG8_LDB(B0, 0, 0); PG8_SCHED; PG8_LDA(At, 0, 0); PG8_STAGE(PG8_SA(1, 1), a1 + hstepA, voffA);
            PG8_WAIT_L(8); PG8_BAR; PG8_WAIT_L(0); PG8_MMA(0, 0, At, B0); PG8_BAR; PG8_SCHED;
            PG8_LDB(B1, 0, 1); PG8_STAGE(PG8_SB(0, 0), b2, voffB);
            PG8_BAR; PG8_WAIT_L(0); PG8_MMA(0, 1, At, B1); PG8_BAR;
            PG8_LDA(At, 0, 1); PG8_STAGE(PG8_SA(0, 0), a2, voffA);
            PG8_BAR; PG8_WAIT_L(0); PG8_MMA(1, 0, At, B0); PG8_BAR; PG8_SCHED;
            PG8_STAGE(PG8_SB(0, 1), b2 + hstep, voffB);
            PG8_WAIT_V(6); PG8_BAR; PG8_MMA(1, 1, At, B1); PG8_BAR;
            PG8_LDB(B0, 1, 0); PG8_SCHED; PG8_LDA(At, 1, 0); PG8_STAGE(PG8_SA(0, 1), a2 + hstepA, voffA);
            PG8_WAIT_L(8); PG8_BAR; PG8_WAIT_L(0); PG8_MMA(0, 0, At, B0); PG8_BAR; PG8_SCHED;
            PG8_LDB(B1, 1, 1); PG8_STAGE(PG8_SB(1, 0), b3, voffB);
            PG8_BAR; PG8_WAIT_L(0); PG8_MMA(0, 1, At, B1); PG8_BAR;
            PG8_LDA(At, 1, 1); PG8_STAGE(PG8_SA(1, 0), a3, voffA);
            PG8_BAR; PG8_WAIT_L(0); PG8_MMA(1, 0, At, B0); PG8_BAR; PG8_SCHED;
            PG8_STAGE(PG8_SB(1, 1), b3 + hstep, voffB);
            PG8_WAIT_V(6); PG8_BAR; PG8_MMA(1, 1, At, B1); PG8_BAR;
            }
        }
        if constexpr (ALIGN_EPI) { if (wr == 0) PG8_BAR; }
        if constexpr (!Epi::AFTER_DRAIN) { E(acc, cur, wr, wc, fr, fq); S.done(cur); }
        if (!has_next) break;
#pragma unroll
        for (int a = 0; a < 2; ++a)
#pragma unroll
            for (int b = 0; b < 2; ++b)
#pragma unroll
                for (int m = 0; m < 4; ++m)
#pragma unroll
                    for (int n = 0; n < 2; ++n) acc[a][b][m][n] = (f32x4){0.f, 0.f, 0.f, 0.f};
        cur = nxt; cA = nA; cB = nB; ++ui;
        if constexpr (ALIGN_EPI) { if (wr == 1) PG8_BAR; }
    }
    PG8_WAIT_V(0);
    if constexpr (!ALIGN_EPI) { if (wr == 0) PG8_BAR; }
    PG8_BAR;
    if constexpr (Epi::AFTER_DRAIN) { E.fused(acc, cur, wr, wc, fr, fq, lds, wid, lane); S.done(cur); }
#undef PG8_SA
#undef PG8_SB
#undef PG8_STAGE
#undef PG8_LDA
#undef PG8_LDB
#undef PG8_MMA
#undef PG8_WAIT_V
#undef PG8_WAIT_L
#undef PG8_BAR
#undef PG8_SCHED
}
}


namespace hy {
using pg8::bf16_t; using pg8::bf16x8; using pg8::f32x4; using pg8::u32x4; using pg8::cvt_pk_bf16; using pg8::lds_byte;
typedef unsigned u32x2 __attribute__((ext_vector_type(2)));
typedef float f32x2 __attribute__((ext_vector_type(2)));
constexpr int T = 32768, D = 2048, SEQ = 16384, NC = 128, NH = 8, DIN = 14352, N1 = 14336, LDP = 10240, NU = 2048;
constexpr int LDS_BYTES = 147456;
constexpr size_t OFF_P = 0;
constexpr size_t OFF_BT2 = OFF_P + (size_t)T * LDP * 2;
constexpr size_t OFF_CST = OFF_BT2 + (size_t)2048 * 4096 * 2;
constexpr size_t OFF_NSTB = OFF_CST + (size_t)NU * 32768 * 2;
constexpr size_t OFF_DN = OFF_NSTB + (size_t)NU * 128 * 2;
constexpr size_t OFF_GI = OFF_DN + (size_t)NU * 128 * 4;
constexpr size_t OFF_GF = OFF_GI + (size_t)T * 8 * 4;
constexpr size_t OFF_RSTD = OFF_GF + (size_t)T * 8 * 4;
constexpr size_t OFF_ROWSS = OFF_RSTD + (size_t)T * 4;
constexpr size_t OFF_BL = OFF_ROWSS + (size_t)T * 4;
constexpr size_t OFF_MLOC = OFF_BL + (size_t)NU * 4;
constexpr size_t OFF_MST = OFF_MLOC + (size_t)NU * 4;
constexpr size_t OFF_WSV = OFF_MST + (size_t)NU * 4;
constexpr size_t OFF_GS = OFF_WSV + (size_t)T * 8 * 4;
constexpr size_t OFF_BT = OFF_GS + (size_t)T * 8 * 4;
constexpr size_t OFF_CM = OFF_BT + (size_t)T * 8 * 4;
constexpr size_t OFF_BAR = OFF_CM + (size_t)T * 8 * 4;
constexpr size_t WS_END = OFF_BAR + 16384;
constexpr int XB_LDS_OFF = LDS_BYTES - 16;
constexpr size_t OUT_OFF_BT1 = (size_t)T * D * 2;

struct Params {
    const float *x, *norm_w, *w_in, *conv_w, *conv_b, *b_i, *b_f, *mnorm_w, *sgu_w, *sgu_b, *w_sp, *b_sp, *w_out, *fnorm_w;
    float* out; unsigned char* ws;
};

__device__ __forceinline__ float bf_lo(unsigned w) { return __uint_as_float(w << 16); }
__device__ __forceinline__ float bf_hi(unsigned w) { return __uint_as_float(w & 0xffff0000u); }
__device__ __forceinline__ float fexp(float x) { return __builtin_amdgcn_exp2f(x * 1.4426950408889634f); }
__device__ __forceinline__ float frcp(float x) { return __builtin_amdgcn_rcpf(x); }
__device__ __forceinline__ int tile_off(int R, int r, int c) { return (c >> 6) * (R * 128) + lds_byte(r, c & 63); }
__device__ __forceinline__ f32x4 mma(bf16x8 X, bf16x8 Y, f32x4 acc) { return __builtin_amdgcn_mfma_f32_16x16x32_bf16(X, Y, acc, 0, 0, 0); }
__device__ __forceinline__ void lds_wait() { asm volatile("s_waitcnt lgkmcnt(0)" ::: "memory"); }
__device__ __forceinline__ float wave_scan_add(float v, int lane) {
#pragma unroll
    for (int o = 1; o < 64; o <<= 1) { const float t = __shfl_up(v, o); if (lane >= o) v += t; }
    return v;
}
__device__ __forceinline__ float wave_scan_max(float v, int lane) {
#pragma unroll
    for (int o = 1; o < 64; o <<= 1) { const float t = __shfl_up(v, o); if (lane >= o) v = fmaxf(v, t); }
    return v;
}
__device__ __forceinline__ float wave_max(float v) {
#pragma unroll
    for (int o = 1; o < 64; o <<= 1) v = fmaxf(v, __shfl_xor(v, o));
    return v;
}

struct Epi1 {
    static constexpr bool PERM = true, AFTER_DRAIN = false;
    bf16_t* P; bool plain;
    __device__ __forceinline__ void operator()(const f32x4 (&acc)[2][2][4][2], const pg8::Unit& u, int wr, int wc, int fr, int fq) const {
        const int row0 = u.pm * 256 + wr * 64 + fr, cw = wc * 32 + 8 * fq; const int pn = plain ? (u.pn % 16) : u.pn;
        if (pn < 16) {
#pragma unroll
            for (int ai = 0; ai < 2; ++ai)
#pragma unroll
                for (int m = 0; m < 4; ++m) { const int row = row0 + ai * 128 + m * 16; bf16_t* rp = P + (size_t)row * LDP + pn * 256 + cw;
#pragma unroll
                    for (int bj = 0; bj < 2; ++bj) { const f32x4 v0 = acc[ai][bj][m][0], v1 = acc[ai][bj][m][1];
                        u32x4 w; w.x = cvt_pk_bf16(v0[0], v0[1]); w.y = cvt_pk_bf16(v0[2], v0[3]); w.z = cvt_pk_bf16(v1[0], v1[1]); w.w = cvt_pk_bf16(v1[2], v1[3]);
                        *(u32x4*)(rp + bj * 128) = w; } }
        } else if (pn < 48) {
            const bool isg = pn >= 32; const int colb = (isg ? 6144 + (pn - 32) * 128 : 4096 + (pn - 16) * 128) + cw;
#pragma unroll
            for (int ai = 0; ai < 2; ++ai)
#pragma unroll
                for (int m = 0; m < 4; ++m) { const int row = row0 + ai * 128 + m * 16; float r[8];
#pragma unroll
                    for (int n = 0; n < 2; ++n)
#pragma unroll
                        for (int j = 0; j < 4; ++j) { const float a = acc[ai][0][m][n][j], z = acc[ai][1][m][n][j];
                            const float arg = isg ? 1.5957691216f * (a + 0.044715f * a * a * a) : a; const float mult = isg ? a * z : z;
                            r[n * 4 + j] = mult * frcp((1.0f + fexp(-arg)) * (1.0f + fexp(-z))); }
                    u32x4 w; w.x = cvt_pk_bf16(r[0], r[1]); w.y = cvt_pk_bf16(r[2], r[3]); w.z = cvt_pk_bf16(r[4], r[5]); w.w = cvt_pk_bf16(r[6], r[7]);
                    *(u32x4*)(P + (size_t)row * LDP + colb) = w; }
        } else {
            const int colb = 8192 + (pn - 48) * 256 + cw;
#pragma unroll
            for (int ai = 0; ai < 2; ++ai)
#pragma unroll
                for (int m = 0; m < 4; ++m) { const int row = row0 + ai * 128 + m * 16;
#pragma unroll
                    for (int bj = 0; bj < 2; ++bj) { float r[8];
#pragma unroll
                        for (int n = 0; n < 2; ++n)
#pragma unroll
                            for (int j = 0; j < 4; ++j) { const float a = acc[ai][bj][m][n][j]; r[n * 4 + j] = a * frcp(1.0f + fexp(-1.5957691216f * (a + 0.044715f * a * a * a))); }
                        u32x4 w; w.x = cvt_pk_bf16(r[0], r[1]); w.y = cvt_pk_bf16(r[2], r[3]); w.z = cvt_pk_bf16(r[4], r[5]); w.w = cvt_pk_bf16(r[6], r[7]);
                        *(u32x4*)(P + (size_t)row * LDP + colb + bj * 128) = w; } }
        }
    }
};
struct Epi2 {
    static constexpr bool PERM = false, AFTER_DRAIN = false;
    const float* x; float* hout; float* rowss; bool dry;
    __device__ __forceinline__ void operator()(const f32x4 (&acc)[2][2][4][2], const pg8::Unit& u, int wr, int wc, int fr, int fq) const {
        const int row0 = u.pm * 256 + wr * 64 + fr, col0 = u.pn * 256 + wc * 32 + 4 * fq;
#pragma unroll
        for (int ai = 0; ai < 2; ++ai)
#pragma unroll
            for (int m = 0; m < 4; ++m) { const int row = row0 + ai * 128 + m * 16; const size_t off = (size_t)row * D + col0; float ss = 0.f;
#pragma unroll
                for (int bj = 0; bj < 2; ++bj)
#pragma unroll
                    for (int n = 0; n < 2; ++n) { const f32x4 xv = *(const f32x4*)(x + off + bj * 128 + n * 16); const f32x4 hv = xv + acc[ai][bj][m][n];
                        *(f32x4*)(hout + off + bj * 128 + n * 16) = hv; ss += (hv[0] * hv[0] + hv[1] * hv[1]) + (hv[2] * hv[2] + hv[3] * hv[3]); }
                ss += __shfl_xor(ss, 16); ss += __shfl_xor(ss, 32);
                if (fq == 0 && !dry) unsafeAtomicAdd(rowss + row, ss);
                asm volatile("" ::: "memory"); }
    }
};

__device__ __forceinline__ int srcmap(int n) {
    if (n < 4096) return n;
    if (n < 8192) { const int j = (n - 4096) >> 8, r = (n - 4096) & 255; return r < 128 ? 4096 + 128 * j + r : 6144 + 128 * j + (r - 128); }
    if (n < 12288) { const int j = (n - 8192) >> 8, r = (n - 8192) & 255; return r < 128 ? 8208 + 128 * j + r : 12304 + 128 * j + (r - 128); }
    return 10256 + (n - 12288);
}
__device__ __forceinline__ void transpose_item(const float* W, int ldw, int scol, int k0, bf16_t* WT, int K, int n0, float* scr, int lane) {
#pragma unroll 8
    for (int i = 0; i < 32; ++i) { const int kk = 2 * i + (lane >> 5); scr[kk * 33 + (lane & 31)] = W[(size_t)(k0 + kk) * ldw + scol + (lane & 31)]; }
    lds_wait();
    const int c = lane & 7;
#pragma unroll
    for (int j = 0; j < 4; ++j) { const int n = (lane >> 3) + 8 * j; const float* s = scr + (8 * c) * 33 + n;
        u32x4 o; o.x = cvt_pk_bf16(s[0 * 33], s[1 * 33]); o.y = cvt_pk_bf16(s[2 * 33], s[3 * 33]); o.z = cvt_pk_bf16(s[4 * 33], s[5 * 33]); o.w = cvt_pk_bf16(s[6 * 33], s[7 * 33]);
        *(u32x4*)(WT + (size_t)(n0 + n) * K + k0 + 8 * c) = o; }
    lds_wait();
}
__device__ __forceinline__ void phase0(const Params& p, unsigned char* lds) {
    const int tid = threadIdx.x, lane = tid & 63, wv = tid >> 6, fr = lane & 15, fq = lane >> 4;
    float* rowss = (float*)(p.ws + OFF_ROWSS);
    for (int i = blockIdx.x * 512 + tid; i < T; i += gridDim.x * 512) rowss[i] = 0.f;
    for (int d = tid; d < D; d += 512) {
        const float* src = p.w_in + (size_t)d * DIN + 8192; float v[16];
#pragma unroll
        for (int i = 0; i < 4; ++i) { const f32x4 t = *(const f32x4*)(src + 4 * i); v[4 * i] = t[0]; v[4 * i + 1] = t[1]; v[4 * i + 2] = t[2]; v[4 * i + 3] = t[3]; }
        const int kb = d >> 5, q = (d & 31) >> 3, e = d & 7;
#pragma unroll
        for (int g = 0; g < 16; ++g) *(unsigned short*)(lds + kb * 1024 + (q * 16 + g) * 16 + e * 2) = (unsigned short)(cvt_pk_bf16(v[g], 0.f) & 0xffffu);
    }
    __syncthreads();
    bf16_t* xs = (bf16_t*)p.out; float* GI = (float*)(p.ws + OFF_GI); float* GF = (float*)(p.ws + OFF_GF);
    for (int wt = blockIdx.x * 8 + wv; wt < T / 16; wt += gridDim.x * 8) {
        const int r0 = wt * 16;
        f32x4 nw[8];
#pragma unroll
        for (int j = 0; j < 8; ++j) nw[j] = *(const f32x4*)(p.norm_w + 4 * lane + 256 * j);
#pragma unroll 2
        for (int r = 0; r < 16; ++r) {
            const float* xr = p.x + (size_t)(r0 + r) * D + 4 * lane; f32x4 v[8]; float ss = 0.f;
#pragma unroll
            for (int j = 0; j < 8; ++j) v[j] = *(const f32x4*)(xr + 256 * j);
#pragma unroll
            for (int j = 0; j < 8; ++j) ss += (v[j][0] * v[j][0] + v[j][1] * v[j][1]) + (v[j][2] * v[j][2] + v[j][3] * v[j][3]);
#pragma unroll
            for (int o = 1; o < 64; o <<= 1) ss += __shfl_xor(ss, o);
            const float rs = 1.0f / sqrtf(ss * (1.0f / D) + 1e-6f);
            bf16_t* orow = xs + (size_t)(r0 + r) * D + 4 * lane;
#pragma unroll
            for (int j = 0; j < 8; ++j) { const f32x4 o4 = v[j] * rs * nw[j]; u32x2 pk; pk.x = cvt_pk_bf16(o4[0], o4[1]); pk.y = cvt_pk_bf16(o4[2], o4[3]); *(u32x2*)(orow + 256 * j) = pk; }
        }
        __builtin_amdgcn_fence(__ATOMIC_RELEASE, "workgroup"); asm volatile("s_waitcnt vmcnt(0)" ::: "memory"); __builtin_amdgcn_fence(__ATOMIC_ACQUIRE, "workgroup");
        const int row = r0 + fr; const bf16_t* xsr = xs + (size_t)row * D + fq * 8;
        f32x4 acc = (f32x4){0.f, 0.f, 0.f, 0.f};
#pragma unroll 8
        for (int kb = 0; kb < 64; ++kb) { const bf16x8 Y = *(const bf16x8*)(xsr + kb * 32); const bf16x8 X = *(const bf16x8*)(lds + kb * 1024 + lane * 16); acc = mma(X, Y, acc); }
        const int b = row >> 14, s = row & (SEQ - 1);
#pragma unroll
        for (int j = 0; j < 4; ++j) { const int g = 4 * fq + j; const float v = acc[j];
            if (g < 8) GI[(size_t)(b * 8 + g) * SEQ + s] = v + p.b_i[g];
            else { const float z = v + p.b_f[g - 8]; GF[(size_t)(b * 8 + g - 8) * SEQ + s] = fminf(z, 0.f) - log1pf(__expf(-fabsf(z))); } }
    }
    float* scr = (float*)(lds + 65536 + wv * 8448);
    bf16_t* Bt1 = (bf16_t*)((unsigned char*)p.out + OUT_OFF_BT1); bf16_t* Bt2 = (bf16_t*)(p.ws + OFF_BT2);
    constexpr int NIT1 = 32 * 448, NIT2 = 64 * 64;
    for (int it = blockIdx.x * 8 + wv; it < NIT1 + NIT2; it += gridDim.x * 8) {
        if (it < NIT1) { const int kb = it / 448, nb = it % 448; transpose_item(p.w_in, DIN, srcmap(32 * nb), 64 * kb, Bt1, D, 32 * nb, scr, lane); }
        else { const int r = it - NIT1, kb = r >> 6, nb = r & 63; transpose_item(p.w_out, D, 32 * nb, 64 * kb, Bt2, 4096, 32 * nb, scr, lane); }
    }
}

__device__ __forceinline__ void gate_prep(const Params& p) {
    const int tid = threadIdx.x, lane = tid & 63, wv = tid >> 6;
    for (int u = blockIdx.x * 8 + wv; u < NU; u += gridDim.x * 8) {
        const int h = u & 7, n = (u >> 3) & 127, b = u >> 10; const size_t base = (size_t)(b * 8 + h) * SEQ + n * 128 + 2 * lane;
        const f32x2 i2 = *(const f32x2*)((const float*)(p.ws + OFF_GI) + base), f2 = *(const f32x2*)((const float*)(p.ws + OFF_GF) + base);
        const float pr = f2.x + f2.y, inc = wave_scan_add(pr, lane), exc = inc - pr, b0 = exc + f2.x, b1 = inc, bL = __shfl(inc, 63);
        const float wl0 = bL - b0 + i2.x, wl1 = bL - b1 + i2.y, ml = wave_max(fmaxf(wl0, wl1));
        const float g0 = i2.x - b0, g1 = i2.y - b1; const float incm = wave_scan_max(fmaxf(g0, g1), lane); float excm = __shfl_up(incm, 1); if (lane == 0) excm = -3.0e38f;
        *(f32x2*)((float*)(p.ws + OFF_WSV) + base) = (f32x2){fexp(wl0 - ml), fexp(wl1 - ml)};
        *(f32x2*)((float*)(p.ws + OFF_GS) + base) = (f32x2){g0, g1};
        *(f32x2*)((float*)(p.ws + OFF_BT) + base) = (f32x2){b0, b1};
        *(f32x2*)((float*)(p.ws + OFF_CM) + base) = (f32x2){fmaxf(excm, g0), incm};
        if (lane == 0) { ((float*)(p.ws + OFF_BL))[u] = bL; ((float*)(p.ws + OFF_MLOC))[u] = ml; }
    }
}
__device__ __forceinline__ void conv_load(const bf16_t* src, int s, bool first, u32x4 (&raw)[7]) {
#pragma unroll
    for (int i = 0; i < 7; ++i) { const int r = s - 3 + i; raw[i] = (u32x4){0u, 0u, 0u, 0u}; if (!(first && r < 0)) raw[i] = *(const u32x4*)(src + (ptrdiff_t)r * LDP); }
}
__device__ __forceinline__ void conv_tab_load(const Params& p, float* tab, int h, int which) {
    for (int i = threadIdx.x; i < 640; i += 512) { const int j = i >> 7, c = i & 127; tab[i] = (j < 4) ? p.conv_w[j * 2048 + which * 1024 + h * 128 + c] : p.conv_b[which * 1024 + h * 128 + c]; }
}
__device__ __forceinline__ void conv_silu(const u32x4 (&raw)[7], const float* tabc, float scale, float (&y)[4][8]) {
    float xin[7][8];
#pragma unroll
    for (int i = 0; i < 7; ++i) { const u32x4 w = raw[i];
        xin[i][0] = bf_lo(w.x); xin[i][1] = bf_hi(w.x); xin[i][2] = bf_lo(w.y); xin[i][3] = bf_hi(w.y); xin[i][4] = bf_lo(w.z); xin[i][5] = bf_hi(w.z); xin[i][6] = bf_lo(w.w); xin[i][7] = bf_hi(w.w); }
#pragma unroll
    for (int hf = 0; hf < 2; ++hf) { f32x4 acc[4]; const f32x4 bias = *(const f32x4*)(tabc + 512 + 4 * hf);
#pragma unroll
        for (int r = 0; r < 4; ++r) acc[r] = bias;
#pragma unroll
        for (int j = 0; j < 4; ++j) { const f32x4 w = *(const f32x4*)(tabc + j * 128 + 4 * hf);
#pragma unroll
            for (int r = 0; r < 4; ++r)
#pragma unroll
                for (int e = 0; e < 4; ++e) acc[r][e] += w[e] * xin[r + j][4 * hf + e]; }
#pragma unroll
        for (int r = 0; r < 4; ++r)
#pragma unroll
            for (int e = 0; e < 4; ++e) { const float v = acc[r][e]; y[r][4 * hf + e] = scale * v * frcp(1.0f + fexp(-v)); } }
}
__device__ __forceinline__ void write_T8(unsigned char* tile, int R, int c0, int s0, const u32x4 (&w)[8]) {
#pragma unroll
    for (int e = 0; e < 8; ++e) { u32x4 o;
#pragma unroll
        for (int q = 0; q < 4; ++q) { const unsigned a = w[2 * q][e >> 1], b = w[2 * q + 1][e >> 1]; o[q] = (e & 1) ? ((a >> 16) | (b & 0xffff0000u)) : ((a & 0xffffu) | (b << 16)); }
        *(u32x4*)(tile + tile_off(R, c0 + e, s0)) = o; }
}

constexpr int P2_CT = 102400;
__device__ __forceinline__ void mlstm_pass1(const Params& p, unsigned char* lds, int u) {
    const int tid = threadIdx.x, lane = tid & 63, wv = tid >> 6, fr = lane & 15, fq = lane >> 4;
    const int h = u & 7, n = (u >> 3) & 127, b = u >> 10; const int row0 = b * SEQ + n * 128;
    unsigned char* kwT = lds; unsigned char* vT = lds + 32768;
    const bf16_t* P = (const bf16_t*)(p.ws + OFF_P);
    const int cgv = (lane & 7) + 8 * (wv >> 1), rgv = (lane >> 3) + 8 * (wv & 1), cgk = tid & 15, rgk = tid >> 4;
    u32x4 vr[8];
    { const bf16_t* src = P + (size_t)(row0 + 8 * rgv) * LDP + 2048 + h * 256 + 8 * cgv;
#pragma unroll
        for (int i = 0; i < 8; ++i) vr[i] = *(const u32x4*)(src + (size_t)i * LDP); }
    u32x4 kr[7]; conv_load(P + (size_t)row0 * LDP + 1024 + h * 128 + 8 * cgk, 4 * rgk, n == 0, kr);
    const f32x4 wq = *(const f32x4*)((const float*)(p.ws + OFF_WSV) + (size_t)(b * 8 + h) * SEQ + n * 128 + 4 * rgk);
    write_T8(vT, 272, 8 * cgv, 8 * rgv, vr);
    if (tid < 16) { const unsigned one2 = 0x3f803f80u; *(u32x4*)(vT + tile_off(272, 256, 8 * tid)) = (u32x4){one2, one2, one2, one2}; }
    else if (tid < 256) { const int pc = tid - 16; *(u32x4*)(vT + tile_off(272, 257 + (pc >> 4), 8 * (pc & 15))) = (u32x4){0u, 0u, 0u, 0u}; }
    { float y[4][8]; conv_silu(kr, (const float*)(lds + P2_CT) + 8 * cgk, 0.08838834764831845f, y);
#pragma unroll
        for (int e = 0; e < 8; ++e) { u32x2 o; o.x = cvt_pk_bf16(y[0][e] * wq[0], y[1][e] * wq[1]); o.y = cvt_pk_bf16(y[2][e] * wq[2], y[3][e] * wq[3]);
            *(u32x2*)(kwT + tile_off(128, 8 * cgk + e, 4 * rgk)) = o; } }
    __syncthreads();
    bf16x8 Yk[4];
#pragma unroll
    for (int kb = 0; kb < 4; ++kb) Yk[kb] = *(const bf16x8*)(kwT + tile_off(128, 16 * wv + fr, 32 * kb + 8 * fq));
    float* dC = (float*)p.out + (size_t)u * 32768; float* dn = (float*)(p.ws + OFF_DN) + (size_t)u * 128;
#pragma unroll
    for (int nb = 0; nb < 17; ++nb) { f32x4 acc = (f32x4){0.f, 0.f, 0.f, 0.f};
#pragma unroll
        for (int kb = 0; kb < 4; ++kb) { const bf16x8 X = *(const bf16x8*)(vT + tile_off(272, 16 * nb + fr, 32 * kb + 8 * fq)); acc = mma(X, Yk[kb], acc); }
        if (nb < 16) {
#pragma unroll
            for (int j = 0; j < 4; ++j) dC[(16 * nb + 4 * fq + j) * 128 + 16 * wv + fr] = acc[j];
        } else if (fq == 0) dn[16 * wv + fr] = acc[0]; }
    __syncthreads();
}

__device__ __forceinline__ void gmlp_unit(const Params& p, unsigned char* lds, int u, bool dry) {
    const int tid = threadIdx.x, lane = tid & 63, wv = tid >> 6, fr = lane & 15, fq = lane >> 4;
    const int h = u & 7, n = (u >> 3) & 127, b = u >> 10; const int row0 = b * SEQ + n * 128;
    bf16_t* P = (bf16_t*)(p.ws + OFF_P); unsigned char* vT = lds;
    const int cg = tid & 31, rg = tid >> 5, t = 16 * wv + fr, wlim = wv >> 1;
    u32x4 raw[8];
    { const bf16_t* src = P + (size_t)(row0 + 8 * rg) * LDP + 8192 + h * 256 + 8 * cg;
#pragma unroll
        for (int i = 0; i < 8; ++i) raw[i] = *(const u32x4*)(src + (size_t)i * LDP); }
    const f32x4 lw0 = *(const f32x4*)(p.sgu_w + h * 256 + 8 * cg), lw1 = *(const f32x4*)(p.sgu_w + h * 256 + 8 * cg + 4);
    const f32x4 lb0 = *(const f32x4*)(p.sgu_b + h * 256 + 8 * cg), lb1 = *(const f32x4*)(p.sgu_b + h * 256 + 8 * cg + 4);
    f32x4 wsp[4][2];
    { const float* wr = p.w_sp + (size_t)h * 16384 + (size_t)t * 128 + 8 * fq;
#pragma unroll
        for (int kb = 0; kb < 4; ++kb) { wsp[kb][0] = (f32x4){0.f, 0.f, 0.f, 0.f}; wsp[kb][1] = wsp[kb][0]; if (kb <= wlim) { wsp[kb][0] = *(const f32x4*)(wr + 32 * kb); wsp[kb][1] = *(const f32x4*)(wr + 32 * kb + 4); } } }
    const float bsp = p.b_sp[h * 128 + t];
    bf16_t* gp = P + (size_t)(row0 + t) * LDP + 6144 + h * 256 + 4 * fq;
    u32x2 gu[16];
#pragma unroll
    for (int nb = 0; nb < 16; ++nb) gu[nb] = *(const u32x2*)(gp + 16 * nb);
    { u32x4 w[8];
#pragma unroll
        for (int i = 0; i < 8; ++i) { float v[8]; const u32x4 tt = raw[i];
            v[0] = bf_lo(tt.x); v[1] = bf_hi(tt.x); v[2] = bf_lo(tt.y); v[3] = bf_hi(tt.y); v[4] = bf_lo(tt.z); v[5] = bf_hi(tt.z); v[6] = bf_lo(tt.w); v[7] = bf_hi(tt.w);
            float s = 0.f;
#pragma unroll
            for (int e = 0; e < 8; ++e) s += v[e];
#pragma unroll
            for (int o = 1; o < 32; o <<= 1) s += __shfl_xor(s, o);
            const float mu = s * (1.0f / 256.0f); float q = 0.f;
#pragma unroll
            for (int e = 0; e < 8; ++e) { v[e] -= mu; q += v[e] * v[e]; }
#pragma unroll
            for (int o = 1; o < 32; o <<= 1) q += __shfl_xor(q, o);
            const float rs = 1.0f / sqrtf(q * (1.0f / 256.0f) + 1e-6f);
            w[i].x = cvt_pk_bf16(v[0] * rs * lw0[0] + lb0[0], v[1] * rs * lw0[1] + lb0[1]); w[i].y = cvt_pk_bf16(v[2] * rs * lw0[2] + lb0[2], v[3] * rs * lw0[3] + lb0[3]);
            w[i].z = cvt_pk_bf16(v[4] * rs * lw1[0] + lb1[0], v[5] * rs * lw1[1] + lb1[1]); w[i].w = cvt_pk_bf16(v[6] * rs * lw1[2] + lb1[2], v[7] * rs * lw1[3] + lb1[3]); }
        write_T8(vT, 256, 8 * cg, 8 * rg, w); }
    bf16x8 Yw[4];
#pragma unroll
    for (int kb = 0; kb < 4; ++kb) { const int s0 = 32 * kb + 8 * fq; float f[8] = {wsp[kb][0][0], wsp[kb][0][1], wsp[kb][0][2], wsp[kb][0][3], wsp[kb][1][0], wsp[kb][1][1], wsp[kb][1][2], wsp[kb][1][3]};
#pragma unroll
        for (int e = 0; e < 8; ++e) if (s0 + e > t) f[e] = 0.f;
        u32x4 pk; pk.x = cvt_pk_bf16(f[0], f[1]); pk.y = cvt_pk_bf16(f[2], f[3]); pk.z = cvt_pk_bf16(f[4], f[5]); pk.w = cvt_pk_bf16(f[6], f[7]);
        __builtin_memcpy(&Yw[kb], &pk, 16); }
    __syncthreads();
#pragma unroll
    for (int nb = 0; nb < 16; ++nb) { f32x4 acc = (f32x4){0.f, 0.f, 0.f, 0.f};
#pragma unroll
        for (int kb = 0; kb < 4; ++kb) if (kb <= wlim) { const bf16x8 X = *(const bf16x8*)(vT + tile_off(256, 16 * nb + fr, 32 * kb + 8 * fq)); acc = mma(X, Yw[kb], acc); }
        const u32x2 g = gu[nb];
        u32x2 o; o.x = cvt_pk_bf16(bf_lo(g.x) * (acc[0] + bsp), bf_hi(g.x) * (acc[1] + bsp)); o.y = cvt_pk_bf16(bf_lo(g.y) * (acc[2] + bsp), bf_hi(g.y) * (acc[3] + bsp));
        if (!dry) *(u32x2*)(gp + 16 * nb) = o; }
    __syncthreads();
}

__device__ __forceinline__ void scan_slab(const Params& p, unsigned char* lds, int g) {
    const int tid = threadIdx.x; const int bh = g >> 4, slab = g & 15, b = bh >> 3, h = bh & 7;
    const float* dC = (const float*)p.out; bf16_t* Cst = (bf16_t*)(p.ws + OFF_CST);
    const float* dn = (const float*)(p.ws + OFF_DN); bf16_t* nstb = (bf16_t*)(p.ws + OFF_NSTB);
    const float* bLa = (const float*)(p.ws + OFF_BL); const float* mla = (const float*)(p.ws + OFF_MLOC); float* mst = (float*)(p.ws + OFF_MST);
    const size_t off = (size_t)slab * 2048 + 4 * tid; const bool don = (slab == 0 && tid < 32);
    const int u0 = (b * 128) * 8 + h;
    f32x4 d[8], e[8];
#pragma unroll
    for (int j = 0; j < 8; ++j) { d[j] = *(const f32x4*)(dC + (size_t)(u0 + 8 * j) * 32768 + off); e[j] = don ? *(const f32x4*)(dn + (size_t)(u0 + 8 * j) * 128 + 4 * tid) : (f32x4){0.f, 0.f, 0.f, 0.f}; }
    float* sc = (float*)lds;
    __syncthreads();
    if (tid < 128) { sc[2 * tid] = bLa[u0 + 8 * tid]; sc[2 * tid + 1] = mla[u0 + 8 * tid]; }
    __syncthreads();
    if (tid == 0) { float m = 0.f;
        for (int n = 0; n < 128; ++n) { const float bL = sc[2 * n], ml = sc[2 * n + 1]; if (slab == 0) mst[u0 + 8 * n] = m;
            const float mn = fmaxf(bL + m, ml); sc[2 * n] = fexp(bL + m - mn); sc[2 * n + 1] = fexp(ml - mn); m = mn; } }
    __syncthreads();
    f32x4 C = (f32x4){0.f, 0.f, 0.f, 0.f}, nv = (f32x4){0.f, 0.f, 0.f, 0.f};
    for (int n0 = 0; n0 < 128; n0 += 8) {
#pragma unroll
        for (int j = 0; j < 8; ++j) { const int n = n0 + j, u = u0 + 8 * n;
            u32x2 o; o.x = cvt_pk_bf16(C[0], C[1]); o.y = cvt_pk_bf16(C[2], C[3]); *(u32x2*)(Cst + (size_t)u * 32768 + off) = o;
            if (don) { u32x2 q; q.x = cvt_pk_bf16(nv[0], nv[1]); q.y = cvt_pk_bf16(nv[2], nv[3]); *(u32x2*)(nstb + (size_t)u * 128 + 4 * tid) = q; }
            const f32x2 as = *(const f32x2*)(sc + 2 * n);
            C = as.x * C + as.y * d[j]; nv = as.x * nv + as.y * e[j];
            if (n + 8 < 128) { d[j] = *(const f32x4*)(dC + (size_t)(u + 64) * 32768 + off); if (don) e[j] = *(const f32x4*)(dn + (size_t)(u + 64) * 128 + 4 * tid); } }
    }
}

constexpr int P4_GS = 135168, P4_NV = P4_GS + 512, P4_NW = P4_GS + 1024, P4_CQ = P4_NW + 1024, P4_CK = P4_CQ + 2560;
__device__ __forceinline__ void mlstm_pass3(const Params& p, unsigned char* lds, int u, bool dry) {
    const int tid = threadIdx.x, lane = tid & 63, wv = tid >> 6, fr = lane & 15, fq = lane >> 4;
    const int h = u & 7, n = (u >> 3) & 127, b = u >> 10; const int row0 = b * SEQ + n * 128;
    unsigned char* Qt = lds; unsigned char* Kt = lds + 32768; unsigned char* vT = lds + 65536; unsigned char* CTt = lds;
    float* gsl = (float*)(lds + P4_GS); unsigned char* nvl = lds + P4_NV; const float* nwl = (const float*)(lds + P4_NW);
    bf16_t* P = (bf16_t*)(p.ws + OFF_P);
    const size_t gbase = (size_t)(b * 8 + h) * SEQ + n * 128; const int t = 16 * wv + fr, wlim = wv >> 1;
    const int cgv = (lane & 7) + 8 * (wv >> 1), rgv = (lane >> 3) + 8 * (wv & 1), cgk = tid & 15, rgk = tid >> 4;
    u32x4 vr[8];
    { const bf16_t* src = P + (size_t)(row0 + 8 * rgv) * LDP + 2048 + h * 256 + 8 * cgv;
#pragma unroll
        for (int i = 0; i < 8; ++i) vr[i] = *(const u32x4*)(src + (size_t)i * LDP); }
    u32x4 qr[7], kr[7];
    conv_load(P + (size_t)row0 * LDP + h * 128 + 8 * cgk, 4 * rgk, n == 0, qr);
    conv_load(P + (size_t)row0 * LDP + 1024 + h * 128 + 8 * cgk, 4 * rgk, n == 0, kr);
    const float mprev = ((const float*)(p.ws + OFF_MST))[u];
    const float cmt = ((const float*)(p.ws + OFF_CM))[gbase + t], bt = ((const float*)(p.ws + OFF_BT))[gbase + t];
    float gsx = 0.f; u32x4 nvx = (u32x4){0u, 0u, 0u, 0u};
    if (tid < 128) gsx = ((const float*)(p.ws + OFF_GS))[gbase + tid];
    else if (tid < 144) nvx = *(const u32x4*)((const bf16_t*)(p.ws + OFF_NSTB) + (size_t)u * 128 + 8 * (tid - 128));
    write_T8(vT, 272, 8 * cgv, 8 * rgv, vr);
    if (tid < 16) { const unsigned one2 = 0x3f803f80u; *(u32x4*)(vT + tile_off(272, 256, 8 * tid)) = (u32x4){one2, one2, one2, one2}; }
    else if (tid < 256) { const int pc = tid - 16; *(u32x4*)(vT + tile_off(272, 257 + (pc >> 4), 8 * (pc & 15))) = (u32x4){0u, 0u, 0u, 0u}; }
    { float y[4][8]; conv_silu(qr, (const float*)(lds + P4_CQ) + 8 * cgk, 1.0f, y);
#pragma unroll
        for (int r = 0; r < 4; ++r) { u32x4 o; o.x = cvt_pk_bf16(y[r][0], y[r][1]); o.y = cvt_pk_bf16(y[r][2], y[r][3]); o.z = cvt_pk_bf16(y[r][4], y[r][5]); o.w = cvt_pk_bf16(y[r][6], y[r][7]);
            *(u32x4*)(Qt + tile_off(128, 4 * rgk + r, 8 * cgk)) = o; }
        conv_silu(kr, (const float*)(lds + P4_CK) + 8 * cgk, 0.08838834764831845f, y);
#pragma unroll
        for (int r = 0; r < 4; ++r) { u32x4 o; o.x = cvt_pk_bf16(y[r][0], y[r][1]); o.y = cvt_pk_bf16(y[r][2], y[r][3]); o.z = cvt_pk_bf16(y[r][4], y[r][5]); o.w = cvt_pk_bf16(y[r][6], y[r][7]);
            *(u32x4*)(Kt + tile_off(128, 4 * rgk + r, 8 * cgk)) = o; } }
    if (tid < 128) gsl[tid] = gsx; else if (tid < 144) *(u32x4*)(nvl + 16 * (tid - 128)) = nvx;
    u32x4 ct[8];
    { const bf16_t* CT = (const bf16_t*)(p.ws + OFF_CST) + (size_t)u * 32768;
#pragma unroll
        for (int i = 0; i < 8; ++i) { const int pi = tid + 512 * i; ct[i] = *(const u32x4*)(CT + (pi >> 4) * 128 + 8 * (pi & 15)); } }
    __syncthreads();
    bf16x8 Yq[4];
#pragma unroll
    for (int kb = 0; kb < 4; ++kb) Yq[kb] = *(const bf16x8*)(Qt + tile_off(128, t, 32 * kb + 8 * fq));
    const float Mt = fmaxf(mprev, cmt);
    bf16x8 pa[4];
#pragma unroll
    for (int kb2 = 0; kb2 < 4; ++kb2) { u32x4 pk = (u32x4){0u, 0u, 0u, 0u};
        if (kb2 <= wlim) { float sv[8];
#pragma unroll
            for (int hb = 0; hb < 2; ++hb) { f32x4 acc = (f32x4){0.f, 0.f, 0.f, 0.f}; const int srow = 32 * kb2 + 8 * (fr >> 2) + 4 * hb + (fr & 3);
#pragma unroll
                for (int kb = 0; kb < 4; ++kb) { const bf16x8 X = *(const bf16x8*)(Kt + tile_off(128, srow, 32 * kb + 8 * fq)); acc = mma(X, Yq[kb], acc); }
                const int s0 = 32 * kb2 + 8 * fq + 4 * hb; const f32x4 g4 = *(const f32x4*)(gsl + s0);
#pragma unroll
                for (int j = 0; j < 4; ++j) sv[4 * hb + j] = (s0 + j <= t) ? acc[j] * fexp(g4[j] - Mt) : 0.f; }
            pk.x = cvt_pk_bf16(sv[0], sv[1]); pk.y = cvt_pk_bf16(sv[2], sv[3]); pk.z = cvt_pk_bf16(sv[4], sv[5]); pk.w = cvt_pk_bf16(sv[6], sv[7]); }
        __builtin_memcpy(&pa[kb2], &pk, 16); }
    __syncthreads();
#pragma unroll
    for (int i = 0; i < 8; ++i) { const int pi = tid + 512 * i; *(u32x4*)(CTt + tile_off(256, pi >> 4, 8 * (pi & 15))) = ct[i]; }
    bf16_t* gp = P + (size_t)(row0 + t) * LDP + 4096 + h * 256 + 4 * fq;
    u32x2 gm[16];
#pragma unroll
    for (int nb = 0; nb < 16; ++nb) gm[nb] = *(const u32x2*)(gp + 16 * nb);
    __syncthreads();
    const float decay = fexp(mprev - Mt);
    f32x4 o[17];
#pragma unroll
    for (int nb = 0; nb < 17; ++nb) { f32x4 acc = (f32x4){0.f, 0.f, 0.f, 0.f};
#pragma unroll
        for (int kb = 0; kb < 4; ++kb) { bf16x8 X;
            if (nb < 16) X = *(const bf16x8*)(CTt + tile_off(256, 16 * nb + fr, 32 * kb + 8 * fq));
            else { u32x4 z = (u32x4){0u, 0u, 0u, 0u}; if (fr == 0) z = *(const u32x4*)(nvl + 64 * kb + 16 * fq); __builtin_memcpy(&X, &z, 16); }
            acc = mma(X, Yq[kb], acc); }
        acc *= decay;
#pragma unroll
        for (int kb2 = 0; kb2 < 4; ++kb2) if (kb2 <= wlim) { const bf16x8 X = *(const bf16x8*)(vT + tile_off(272, 16 * nb + fr, 32 * kb2 + 8 * fq)); acc = mma(X, pa[kb2], acc); }
        o[nb] = acc; }
    const float den = __shfl(o[16][0], fr);
    const float inv = frcp(fmaxf(fabsf(den), fexp(-(bt + Mt))));
    float ss = 0.f;
#pragma unroll
    for (int nb = 0; nb < 16; ++nb) { o[nb] *= inv; ss += (o[nb][0] * o[nb][0] + o[nb][1] * o[nb][1]) + (o[nb][2] * o[nb][2] + o[nb][3] * o[nb][3]); }
    ss += __shfl_xor(ss, 16); ss += __shfl_xor(ss, 32);
    const float rn = 1.0f / sqrtf(ss * (1.0f / 256.0f) + 1e-6f);
    const float* nw = nwl + 4 * fq;
#pragma unroll
    for (int nb = 0; nb < 16; ++nb) { const u32x2 g = gm[nb]; const f32x4 w4 = *(const f32x4*)(nw + 16 * nb);
        u32x2 q; q.x = cvt_pk_bf16(o[nb][0] * rn * w4[0] * bf_lo(g.x), o[nb][1] * rn * w4[1] * bf_hi(g.x)); q.y = cvt_pk_bf16(o[nb][2] * rn * w4[2] * bf_lo(g.y), o[nb][3] * rn * w4[3] * bf_hi(g.y));
        if (!dry) *(u32x2*)(gp + 16 * nb) = q; }
    __syncthreads();
}

__device__ __forceinline__ void final_norm(const Params& p, bool dry) {
    const int tid = threadIdx.x, lane = tid & 63, wv = tid >> 6; const float* rowss = (const float*)(p.ws + OFF_ROWSS);
    for (int row = blockIdx.x * 8 + wv; row < T; row += gridDim.x * 8) {
        const float rs = 1.0f / sqrtf(rowss[row] * (1.0f / D) + 1e-6f); float* rp = p.out + (size_t)row * D + 4 * lane;
#pragma unroll
        for (int j = 0; j < 8; ++j) { const f32x4 v = *(const f32x4*)(rp + 256 * j); const f32x4 w = *(const f32x4*)(p.fnorm_w + 4 * lane + 256 * j); if (!dry) *(f32x4*)(rp + 256 * j) = v * rs * w; }
    }
}

#ifndef HY_REP
#define HY_REP 0
#endif
#ifndef HY_SKIP
#define HY_SKIP 0
#endif
struct DryOrder : pg8::StaticOrder {
    __device__ bool next(int i, pg8::Unit& u) const { const bool r = pg8::StaticOrder::next(i, u); u.pm = (c >> 3) & 1; u.pn = c & 1; return r; }
};
__device__ __forceinline__ void run_gemm1(const Params& p, unsigned char* smem, bool plain) {
    gate_prep(p);
    pg8::Gemm g; g.A = (const bf16_t*)p.out; g.Bt = (const bf16_t*)((const unsigned char*)p.out + OUT_OFF_BT1); g.M = T; g.N = N1; g.K = D;
    Epi1 E; E.P = (bf16_t*)(p.ws + OFF_P); E.plain = plain;
#if HY_REP
    if (plain) { DryOrder S; S.init(T, N1, gridDim.x, blockIdx.x); pg8::gemm_phase<Epi1, DryOrder, true, true>((PG8_LAS unsigned char*)smem, g, D, S, E); return; }
#endif
    pg8::StaticOrder S; S.init(T, N1, gridDim.x, blockIdx.x);
    pg8::gemm_phase<Epi1, pg8::StaticOrder, true, true>((PG8_LAS unsigned char*)smem, g, D, S, E);
}
__device__ __forceinline__ void run_gemm2(const Params& p, unsigned char* smem, bool dry) {
    pg8::Gemm g; g.A = (const bf16_t*)(p.ws + OFF_P) + 4096; g.Bt = (const bf16_t*)(p.ws + OFF_BT2); g.M = T; g.N = D; g.K = 4096;
    pg8::StaticOrder S; S.init(T, D, gridDim.x, blockIdx.x);
    Epi2 E; E.x = p.x; E.hout = p.out; E.rowss = (float*)(p.ws + OFF_ROWSS); E.dry = dry;
    pg8::gemm_phase<Epi2, pg8::StaticOrder, true, true>((PG8_LAS unsigned char*)smem, g, LDP, S, E);
}
__device__ __forceinline__ void run_p2(const Params& p, unsigned char* smem, bool dry) {
    int hl = -1;
    for (int it = blockIdx.x; it < 2 * NU; it += gridDim.x) {
        if (it < NU) { const int h = it & 7; if (h != hl) { __syncthreads(); conv_tab_load(p, (float*)(smem + P2_CT), h, 1); __syncthreads(); hl = h; } mlstm_pass1(p, smem, it); }
        else gmlp_unit(p, smem, it - NU, dry); }
}
__device__ __forceinline__ void run_p3(const Params& p, unsigned char* smem) { for (int g = blockIdx.x; g < 256; g += gridDim.x) scan_slab(p, smem, g); }
__device__ __forceinline__ void run_p4(const Params& p, unsigned char* smem, bool dry) {
    int hl = -1;
    for (int it = blockIdx.x; it < NU; it += gridDim.x) {
        const int h = it & 7;
        if (h != hl) { __syncthreads(); conv_tab_load(p, (float*)(smem + P4_CQ), h, 0); conv_tab_load(p, (float*)(smem + P4_CK), h, 1);
            for (int i = threadIdx.x; i < 256; i += 512) ((float*)(smem + P4_NW))[i] = p.mnorm_w[h * 256 + i];
            __syncthreads(); hl = h; }
        mlstm_pass3(p, smem, it, dry); }
}
#define LAS __attribute__((address_space(3)))
#define XB_TMO      128
#define XB_XCNT(j)  (256  + 64 * (j))
#define XB_XSUB(j)  (1280 + 64 * (j))
#define XB_XGEN(j)  (2304 + 64 * (j))
#define XB_TOP      3328
#define XB_TOPGEN   3392
#define XCD_BAR_WORDS 3456
#define XB_SPIN_CAP (1u << 18)

__device__ __forceinline__ unsigned xb_ld(unsigned* p)              { return __hip_atomic_load(p, __ATOMIC_RELAXED, __HIP_MEMORY_SCOPE_AGENT); }
__device__ __forceinline__ unsigned xb_add(unsigned* p, unsigned v) { return __hip_atomic_fetch_add(p, v, __ATOMIC_RELAXED, __HIP_MEMORY_SCOPE_AGENT); }
__device__ __forceinline__ unsigned xb_xcc_id() { return (unsigned)__builtin_amdgcn_s_getreg((3 << 11) | 20) & 0xFu; }
#define XB_SPIN(cond, bar) do { unsigned _sp = 0; while (cond) { __builtin_amdgcn_s_sleep(1); \
    if ((++_sp & 255u) == 0u) { if (xb_ld(&(bar)[XB_TMO])) break; if (_sp > XB_SPIN_CAP) { atomicAdd(&(bar)[XB_TMO], 1u); break; } } } } while (0)

struct XcdBarrier {
    unsigned* bar; unsigned x;
    volatile LAS unsigned* st;
};

__device__ __forceinline__ XcdBarrier xcd_barrier_post(unsigned* bar, volatile LAS unsigned* st) {
    XcdBarrier b; b.bar = bar; b.x = xb_xcc_id(); b.st = st;
    if (threadIdx.x == 0) (void)xb_add(&bar[XB_XCNT(b.x)], 1u);
    return b;
}
__device__ __forceinline__ void xcd_barrier_complete(unsigned* bar, unsigned x, unsigned& nloc, unsigned& nx) {
    const unsigned G = gridDim.x * gridDim.y * gridDim.z;
    unsigned sum, cnt, mine, sp = 0u;
    for (;;) {
        sum = 0u; cnt = 0u; mine = 0u;
#pragma unroll
        for (unsigned j = 0; j < 16; ++j) { const unsigned c = xb_ld(&bar[XB_XCNT(j)]); sum += c; cnt += (c > 0u) ? 1u : 0u; mine = (j == x) ? c : mine; }
        if (sum == G) break;
        __builtin_amdgcn_s_sleep(1);
        if ((++sp & 255u) == 0u) { if (xb_ld(&bar[XB_TMO])) break; if (sp > XB_SPIN_CAP) { atomicAdd(&bar[XB_TMO], 1u); break; } }
    }
    nloc = mine > 0u ? mine : 1u; nx = cnt > 0u ? cnt : 1u;
}

__device__ __forceinline__ void xcd_barrier(const XcdBarrier& b) {
    asm volatile("s_waitcnt vmcnt(0)" ::: "memory");
    __syncthreads();
    if (threadIdx.x == 0) {
        unsigned* bar = b.bar;
        __builtin_amdgcn_s_waitcnt(0);
        unsigned nloc = b.st[0], nx = b.st[1];
        if (nloc == 0u) { xcd_barrier_complete(bar, b.x, nloc, nx); b.st[0] = nloc; b.st[1] = nx; }
        const unsigned old = xb_add(&bar[XB_XSUB(b.x)], 1u);
        const unsigned gen = old / nloc;
        if (old + 1u == (gen + 1u) * nloc) {
            __builtin_amdgcn_fence(__ATOMIC_RELEASE, "agent");
            asm volatile("s_waitcnt vmcnt(0)" ::: "memory");
            const unsigned og = xb_add(&bar[XB_TOP], 1u);
            const unsigned tg = og / nx;
            if (og + 1u == (tg + 1u) * nx) xb_add(&bar[XB_TOPGEN], 1u);
            else XB_SPIN(xb_ld(&bar[XB_TOPGEN]) == tg, bar);
            __builtin_amdgcn_fence(__ATOMIC_ACQUIRE, "agent");
            xb_add(&bar[XB_XGEN(b.x)], 1u);
            asm volatile("s_waitcnt vmcnt(0)" ::: "memory");
        } else {
            XB_SPIN(xb_ld(&bar[XB_XGEN(b.x)]) == gen, bar);
            __builtin_amdgcn_fence(__ATOMIC_ACQUIRE, "agent");
            asm volatile("s_waitcnt vmcnt(0)" ::: "memory");
        }
    }
    __syncthreads();
}


__global__ void __launch_bounds__(512) hymba_fwd(Params p, int rep) {
    extern __shared__ __attribute__((aligned(16))) unsigned char smem[];
    cgx::grid_group grid = cgx::this_grid();
    volatile LAS unsigned* xst = (volatile LAS unsigned*)(LAS unsigned char*)(smem + XB_LDS_OFF);
    if (threadIdx.x == 0) { xst[0] = 0u; xst[1] = 0u; }
    __syncthreads();
    const XcdBarrier xbar = xcd_barrier_post((unsigned*)(p.ws + OFF_BAR), xst);
#if HY_REP
    if (rep & 1) { phase0(p, smem); grid.sync(); }
#endif
    if (!((HY_SKIP >> 0) & 1)) {
    phase0(p, smem); }
    grid.sync();
#if HY_REP
    if (rep & 2) { run_gemm1(p, smem, true); grid.sync(); }
#endif
    if (!((HY_SKIP >> 1) & 1)) {
    run_gemm1(p, smem, false); }
    xcd_barrier(xbar);
#if HY_REP
    if (rep & 4) { run_p2(p, smem, true); grid.sync(); }
#endif
    if (!((HY_SKIP >> 2) & 1)) {
    run_p2(p, smem, false); }
    xcd_barrier(xbar);
#if HY_REP
    if (rep & 8) { run_p3(p, smem); grid.sync(); }
#endif
    if (!((HY_SKIP >> 3) & 1)) {
    run_p3(p, smem); }
    xcd_barrier(xbar);
#if HY_REP
    if (rep & 16) { run_p4(p, smem, true); grid.sync(); }
#endif
    if (!((HY_SKIP >> 4) & 1)) {
    run_p4(p, smem, false); }
    xcd_barrier(xbar);
#if HY_REP
    if (rep & 32) { run_gemm2(p, smem, true); grid.sync(); }
#endif
    if (!((HY_SKIP >> 5) & 1)) {
    run_gemm2(p, smem, false); }
    xcd_barrier(xbar);
#if HY_REP
    if (rep & 64) { final_norm(p, true); grid.sync(); }
#endif
    final_norm(p, false);
}
}

extern "C" void kernel_launch(void* const* d_in, const int* in_sizes, int n_in, void* d_out, int out_size, void* d_ws, size_t ws_size, hipStream_t stream) {
    static int grid = 0;
    if (grid == 0) {
        if (n_in != 14 || out_size != hy::T * hy::D || ws_size < hy::WS_END) { fprintf(stderr, "kernel_launch: unexpected sizes (n_in %d out %d ws %zu need %zu)\n", n_in, out_size, ws_size, (size_t)hy::WS_END); grid = -1; return; }
        int dev = 0, cus = 0, per_cu = 0;
        (void)hipGetDevice(&dev); (void)hipDeviceGetAttribute(&cus, hipDeviceAttributeMultiprocessorCount, dev);
        if (hipFuncSetAttribute((const void*)hy::hymba_fwd, hipFuncAttributeMaxDynamicSharedMemorySize, hy::LDS_BYTES) != hipSuccess) { fprintf(stderr, "kernel_launch: hipFuncSetAttribute failed\n"); grid = -1; return; }
        if (hipOccupancyMaxActiveBlocksPerMultiprocessor(&per_cu, (const void*)hy::hymba_fwd, 512, hy::LDS_BYTES) != hipSuccess || per_cu < 1) { fprintf(stderr, "kernel_launch: occupancy query says %d\n", per_cu); per_cu = 1; }
        (void)hipGetLastError();
        grid = cus > 0 ? cus : 256;
    }
    if (grid < 0) return;
    hy::Params p{};
    p.x = (const float*)d_in[0]; p.norm_w = (const float*)d_in[1]; p.w_in = (const float*)d_in[2]; p.conv_w = (const float*)d_in[3]; p.conv_b = (const float*)d_in[4];
    p.b_i = (const float*)d_in[5]; p.b_f = (const float*)d_in[6]; p.mnorm_w = (const float*)d_in[7]; p.sgu_w = (const float*)d_in[8]; p.sgu_b = (const float*)d_in[9];
    p.w_sp = (const float*)d_in[10]; p.b_sp = (const float*)d_in[11]; p.w_out = (const float*)d_in[12]; p.fnorm_w = (const float*)d_in[13];
    p.out = (float*)d_out; p.ws = (unsigned char*)d_ws;
    if (hipMemsetAsync((unsigned char*)d_ws + hy::OFF_BAR, 0, 16384, stream) != hipSuccess) { fprintf(stderr, "kernel_launch: memset of the barrier words failed\n"); return; }
    int rep = HY_REP; void* args[] = {&p, &rep};
    hipError_t e = hipLaunchCooperativeKernel((const void*)hy::hymba_fwd, dim3(grid), dim3(512), args, hy::LDS_BYTES, stream);
    if (e != hipSuccess) fprintf(stderr, "cooperative launch failed: %s (grid %d)\n", hipGetErrorString(e), grid);
}
```
